# Optimizing an MI355X kernel written in HIP

```python
import jax
import jax.numpy as jnp
from jax import lax
import numpy as np

D_MODEL = 1024
BATCH = 16
SEQ = 256
DEPTH = 4
DEC_BATCH = 8
DEC_SEQ = 1024
PAST_LEN = 512

GRID_W = 64
D_HEAD = 64
ML_HEADS = D_MODEL // (4 * D_HEAD)
SWA_HEADS = (3 * D_MODEL) // (8 * D_HEAD)
SWA_KV_HEADS = SWA_HEADS // 3
NAT_HEADS = (3 * D_MODEL) // (8 * D_HEAD)
ML_W = ML_HEADS * D_HEAD
SWA_W = SWA_HEADS * D_HEAD
SWA_KV_W = SWA_KV_HEADS * D_HEAD
NAT_W = NAT_HEADS * D_HEAD
MIX_W = ML_W + SWA_W + NAT_W
N_GATES = 4 * ML_HEADS
IN_SIZES = (ML_W, ML_W, ML_W, ML_W, N_GATES, SWA_W, SWA_KV_W, SWA_KV_W, NAT_W, NAT_W, NAT_W)
IN_DIM = sum(IN_SIZES)
D_FF = 4 * D_MODEL
ML_CHUNK = 64
SWA_WINDOW = 128
SWA_BLOCK = 128
NAT_KH = 8
NAT_KW = 16
NAT_QB = 16
NAT_KC = NAT_QB + NAT_KW
ROPE_BASE = 10000.0
LN_EPS = 1e-5
DN_ALPHA = (2 * DEPTH) ** 0.25
DN_BETA = (8 * DEPTH) ** -0.25

kernel_name = 'hybrid_mlstm_swa_natten_flow_step'


def _layer_norm(x, g, b):
    xf = x.astype(jnp.float32)
    mu = jnp.mean(xf, axis=-1, keepdims=True)
    var = jnp.mean(jnp.square(xf - mu), axis=-1, keepdims=True)
    y = (xf - mu) * lax.rsqrt(var + LN_EPS) * g.astype(jnp.float32) + b.astype(jnp.float32)
    return y.astype(x.dtype)


def _heads(a, n_heads):
    bsz, t, _ = a.shape
    return a.reshape(bsz, t, n_heads, D_HEAD).transpose(0, 2, 1, 3)


def _merge(a):
    bsz, h, t, d = a.shape
    return a.transpose(0, 2, 1, 3).reshape(bsz, t, h * d)


def _rope_axis(x, pos):
    half = x.shape[-1] // 2
    freqs = ROPE_BASE ** (-jnp.arange(half, dtype=jnp.float32) / half)
    ang = pos.astype(jnp.float32)[:, None] * freqs[None, :]
    cos = jnp.cos(ang).astype(x.dtype)
    sin = jnp.sin(ang).astype(x.dtype)
    x1, x2 = x[..., :half], x[..., half:]
    return jnp.concatenate([x1 * cos - x2 * sin, x1 * sin + x2 * cos], axis=-1)


def _rope_2d(x):
    t = jnp.arange(x.shape[-2])
    half = x.shape[-1] // 2
    return jnp.concatenate([_rope_axis(x[..., :half], t // GRID_W),
                            _rope_axis(x[..., half:], t % GRID_W)], axis=-1)


def _softmax_with_sink(s, sink):
    s = s.astype(jnp.float32)
    sk = jnp.broadcast_to(sink.astype(jnp.float32), s.shape[:-1] + (1,))
    p = jax.nn.softmax(jnp.concatenate([s, sk], axis=-1), axis=-1)
    return p[..., :-1]


def _modulation(cvec, w_ada, b_ada):
    return jnp.split(jax.nn.silu(cvec) @ w_ada + b_ada, 6, axis=-1)


def _split_in(z):
    idx = [int(i) for i in np.cumsum(IN_SIZES)[:-1]]
    return jnp.split(z, idx, axis=-1)


def _mlstm_scan(q, k, v, li, lf, c0, n0, m0):
    bsz, nh, t, d = q.shape
    nc = t // ML_CHUNK

    def chunks(a):
        return jnp.moveaxis(a.reshape((bsz, nh, nc, ML_CHUNK) + a.shape[3:]), 2, 0)

    causal = jnp.tril(jnp.ones((ML_CHUNK, ML_CHUNK), dtype=bool))

    def step(carry, xs):
        c_st, n_st, m_st = carry
        qc, kc, vc, lic, lfc = xs
        b = jnp.cumsum(lfc, axis=-1)
        dmat = jnp.where(causal, b[..., :, None] - b[..., None, :] + lic[..., None, :], -jnp.inf)
        prev = b + m_st[..., None]
        mt = jnp.maximum(prev, jnp.max(dmat, axis=-1))
        wprev = jnp.exp(prev - mt)
        s = jnp.einsum('bhtd,bhsd->bhts', qc, kc) * jnp.exp(dmat - mt[..., None])
        num = s @ vc + wprev[..., None] * jnp.einsum('bhde,bhte->bhtd', c_st, qc)
        den = jnp.sum(s, axis=-1) + wprev * jnp.einsum('bhd,bhtd->bht', n_st, qc)
        h = num / jnp.maximum(jnp.abs(den), jnp.exp(-mt))[..., None]
        m_new = mt[..., -1]
        ws = jnp.exp(b[..., -1:] - b + lic - m_new[..., None])
        wc = wprev[..., -1]
        c_new = wc[..., None, None] * c_st + jnp.einsum('bhs,bhsd,bhse->bhde', ws, vc, kc)
        n_new = wc[..., None] * n_st + jnp.einsum('bhs,bhsd->bhd', ws, kc)
        return (c_new, n_new, m_new), h

    (c_f, n_f, m_f), hs = lax.scan(step, (c0, n0, m0), tuple(chunks(a) for a in (q, k, v, li, lf)))
    h = jnp.moveaxis(hs, 0, 2).reshape(bsz, nh, t, d)
    return h, c_f, n_f, m_f


def _mlstm_mixer(mq, mk, mv, mo, mg, fbias, norm_g, c0, n0, m0):
    out_dtype = mq.dtype
    bsz, t, _ = mq.shape
    f32 = jnp.float32
    q = _heads(mq.astype(f32), ML_HEADS)
    k = _heads(mk.astype(f32), ML_HEADS) * (D_HEAD ** -0.5)
    v = _heads(mv.astype(f32), ML_HEADS)
    g = mg.astype(f32).reshape(bsz, t, 4, ML_HEADS).transpose(2, 0, 3, 1)
    fb = fbias.astype(f32)
    li_f, lf_f = g[0], jax.nn.log_sigmoid(g[1] + fb[0][:, None])
    li_b, lf_b = g[2], jax.nn.log_sigmoid(g[3] + fb[1][:, None])
    c0, n0, m0 = c0.astype(f32), n0.astype(f32), m0.astype(f32)
    h_f, c_f, n_f, m_f = _mlstm_scan(q, k, v, li_f, lf_f, c0[:, 0], n0[:, 0], m0[:, 0])
    flip = lambda a: jnp.flip(a, axis=2)
    h_b, c_b, n_b, m_b = _mlstm_scan(flip(q), flip(k), flip(v), flip(li_b), flip(lf_b),
                                     c0[:, 1], n0[:, 1], m0[:, 1])
    h = h_f + flip(h_b)
    mu = jnp.mean(h, axis=-1, keepdims=True)
    var = jnp.mean(jnp.square(h - mu), axis=-1, keepdims=True)
    h = _merge((h - mu) * lax.rsqrt(var + LN_EPS))
    h = h * norm_g.astype(f32) * jax.nn.sigmoid(mo.astype(f32))
    return (h.astype(out_dtype), jnp.stack([c_f, c_b], axis=1),
            jnp.stack([n_f, n_b], axis=1), jnp.stack([m_f, m_b], axis=1))


def _swa_context(q, k, v, sink):
    bsz, hq, lq, d = q.shape
    grp = hq // SWA_KV_HEADS
    qg = q.reshape(bsz, SWA_KV_HEADS, grp, lq, d)
    s = jnp.einsum('bkgqd,bksd->bkgqs', qg, k) * (d ** -0.5)
    p = _softmax_with_sink(s, sink.reshape(1, SWA_KV_HEADS, grp, 1, 1)).astype(v.dtype)
    return jnp.einsum('bkgqs,bksd->bkgqd', p, v).reshape(bsz, hq, lq, d)


def _swa_latent(q, k, v, ck, cv, sink):
    bsz, hq, t, d = q.shape
    kv = SWA_KV_HEADS
    grp = hq // kv
    bl = SWA_BLOCK
    nb = t // bl
    scale = d ** -0.5
    qb = q.reshape(bsz, kv, grp, nb, bl, d)

    def band(a):
        ap = jnp.pad(a, ((0, 0), (0, 0), (bl, bl), (0, 0))).reshape(bsz, kv, nb + 2, bl, d)
        return jnp.concatenate([ap[:, :, 0:nb], ap[:, :, 1:nb + 1], ap[:, :, 2:nb + 2]], axis=3)

    kb, vb = band(k), band(v)
    qpos = np.arange(nb)[:, None, None] * bl + np.arange(bl)[None, :, None]
    kpos = np.arange(nb)[:, None, None] * bl - bl + np.arange(3 * bl)[None, None, :]
    valid = (np.abs(qpos - kpos) <= SWA_WINDOW) & (kpos >= 0) & (kpos < t)
    s_band = jnp.einsum('bkgnqd,bknsd->bkgnqs', qb, kb).astype(jnp.float32) * scale
    s_band = jnp.where(valid, s_band, -jnp.inf)
    s_ctx = jnp.einsum('bkgnqd,bkcd->bkgnqc', qb, ck).astype(jnp.float32) * scale
    p = _softmax_with_sink(jnp.concatenate([s_band, s_ctx], axis=-1),
                           sink.reshape(1, kv, grp, 1, 1, 1)).astype(v.dtype)
    o = (jnp.einsum('bkgnqs,bknsd->bkgnqd', p[..., :3 * bl], vb)
         + jnp.einsum('bkgnqc,bkcd->bkgnqd', p[..., 3 * bl:], cv))
    return o.reshape(bsz, hq, t, d)


def _dense_attention(q, k, v):
    s = jnp.einsum('bhqd,bhsd->bhqs', q, k) * (q.shape[-1] ** -0.5)
    p = jax.nn.softmax(s.astype(jnp.float32), axis=-1).astype(v.dtype)
    return jnp.einsum('bhqs,bhsd->bhqd', p, v)


def _nat_latent(q, k, v, ck, cv, rpb):
    bsz, nh, t, d = q.shape
    rows = t // GRID_W
    kh = min(NAT_KH, rows)
    ncb = GRID_W // NAT_QB
    scale = d ** -0.5
    r = np.arange(rows)
    rows_idx = np.clip(r - kh // 2, 0, rows - kh)[:, None] + np.arange(kh)[None, :]
    cb = np.arange(ncb)
    cols_idx = (np.clip(cb * NAT_QB - NAT_KW // 2, 0, GRID_W - NAT_KC)[:, None]
                + np.arange(NAT_KC)[None, :])
    qcol = cb[:, None] * NAT_QB + np.arange(NAT_QB)[None, :]
    cs = np.clip(qcol - NAT_KW // 2, 0, GRID_W - NAT_KW)
    kc3 = cols_idx[:, None, :]
    col_ok = (kc3 >= cs[..., None]) & (kc3 < cs[..., None] + NAT_KW)
    roff = rows_idx - r[:, None] + NAT_KH - 1
    coff = np.clip(kc3 - qcol[..., None] + NAT_KW - 1, 0, 2 * NAT_KW - 2)
    bias = rpb[:, roff[:, None, None, :, None], coff[None, :, :, None, :]]
    bias = jnp.where(col_ok[None, None, :, :, None, :], bias.astype(jnp.float32), -jnp.inf)
    qg = q.reshape(bsz, nh, rows, ncb, NAT_QB, d)
    ri = rows_idx[:, None, :, None]
    ci = cols_idx[None, :, None, :]
    kg = k.reshape(bsz, nh, rows, GRID_W, d)[:, :, ri, ci]
    vg = v.reshape(bsz, nh, rows, GRID_W, d)[:, :, ri, ci]
    s_nb = jnp.einsum('bhrcqd,bhrckwd->bhrcqkw', qg, kg).astype(jnp.float32) * scale + bias[None]
    n_nb = kh * NAT_KC
    s_nb = s_nb.reshape(bsz, nh, rows, ncb, NAT_QB, n_nb)
    s_ctx = jnp.einsum('bhrcqd,bhsd->bhrcqs', qg, ck).astype(jnp.float32) * scale
    p = jax.nn.softmax(jnp.concatenate([s_nb, s_ctx], axis=-1), axis=-1).astype(v.dtype)
    p_nb = p[..., :n_nb].reshape(bsz, nh, rows, ncb, NAT_QB, kh, NAT_KC)
    o = (jnp.einsum('bhrcqkw,bhrckwd->bhrcqd', p_nb, vg)
         + jnp.einsum('bhrcqs,bhsd->bhrcqd', p[..., n_nb:], cv))
    return o.reshape(bsz, nh, t, d)


def _residual_tail(x, mix_heads, g_a, sh_m, sc_m, g_m, w_out, ln1_g, ln1_b, w_mlp1, w_mlp2, ln2_g, ln2_b):
    mix = jnp.concatenate(mix_heads, axis=-1) @ w_out
    x = _layer_norm(DN_ALPHA * x + g_a * mix, ln1_g, ln1_b)
    h = x * (1.0 + sc_m) + sh_m
    f = jnp.square(jax.nn.relu(h @ w_mlp1)) @ w_mlp2
    return _layer_norm(DN_ALPHA * x + g_m * f, ln2_g, ln2_b)


def _context_layer(x, c_ctx, w_ada, b_ada, w_in, b_in, fbias, norm_g, sink,
                   w_out, ln1_g, ln1_b, w_mlp1, w_mlp2, ln2_g, ln2_b):
    sh_a, sc_a, g_a, sh_m, sc_m, g_m = _modulation(c_ctx, w_ada, b_ada)
    bsz = x.shape[0]
    h = x * (1.0 + sc_a) + sh_a
    mq, mk, mv, mo, mg, sq, sk, sv, nq, nk, nv = _split_in(h @ w_in + b_in)
    zc = jnp.zeros((bsz, 2, ML_HEADS, D_HEAD, D_HEAD), jnp.float32)
    zn = jnp.zeros((bsz, 2, ML_HEADS, D_HEAD), jnp.float32)
    zm = jnp.zeros((bsz, 2, ML_HEADS), jnp.float32)
    y_ml, st_c, st_n, st_m = _mlstm_mixer(mq, mk, mv, mo, mg, fbias, norm_g, zc, zn, zm)
    k_swa, v_swa = _heads(sk, SWA_KV_HEADS), _heads(sv, SWA_KV_HEADS)
    y_swa = _merge(_swa_context(_heads(sq, SWA_HEADS), k_swa, v_swa, sink))
    k_nat, v_nat = _heads(nk, NAT_HEADS), _heads(nv, NAT_HEADS)
    y_nat = _merge(_dense_attention(_heads(nq, NAT_HEADS), k_nat, v_nat))
    x = _residual_tail(x, [y_ml, y_swa, y_nat], g_a, sh_m, sc_m, g_m,
                       w_out, ln1_g, ln1_b, w_mlp1, w_mlp2, ln2_g, ln2_b)
    return x, (k_swa, v_swa, k_nat, v_nat, st_c, st_n, st_m)


def _latent_layer(x, c, ck_swa, cv_swa, ck_nat, cv_nat, st_c, st_n, st_m,
                  w_ada, b_ada, w_in, b_in, fbias, norm_g, sink, rpb,
                  w_out, ln1_g, ln1_b, w_mlp1, w_mlp2, ln2_g, ln2_b):
    mods = _modulation(c, w_ada, b_ada)
    sh_a, sc_a, g_a, sh_m, sc_m, g_m = [m[:, None, :] for m in mods]
    h = x * (1.0 + sc_a) + sh_a
    mq, mk, mv, mo, mg, sq, sk, sv, nq, nk, nv = _split_in(h @ w_in + b_in)
    y_ml, _, _, _ = _mlstm_mixer(mq, mk, mv, mo, mg, fbias, norm_g, st_c, st_n, st_m)
    y_swa = _merge(_swa_latent(_rope_2d(_heads(sq, SWA_HEADS)), _rope_2d(_heads(sk, SWA_KV_HEADS)),
                               _heads(sv, SWA_KV_HEADS), ck_swa, cv_swa, sink))
    y_nat = _merge(_nat_latent(_heads(nq, NAT_HEADS), _heads(nk, NAT_HEADS), _heads(nv, NAT_HEADS),
                               ck_nat, cv_nat, rpb))
    return _residual_tail(x, [y_ml, y_swa, y_nat], g_a, sh_m, sc_m, g_m,
                          w_out, ln1_g, ln1_b, w_mlp1, w_mlp2, ln2_g, ln2_b)


def setup_inputs(seed: int = 0) -> dict:
    key = jax.random.key(seed)
    ks = jax.random.split(key, 26)

    def nrm(k, shape, scale=1.0):
        return scale * jax.random.normal(k, shape, jnp.float32)

    d = D_MODEL
    return {
        'x_prompt': nrm(ks[0], (BATCH, SEQ, d)),
        'x_sample': nrm(ks[1], (DEC_BATCH, DEC_SEQ, d)),
        'cache_swa_k': nrm(ks[2], (DEC_BATCH, DEPTH, SWA_KV_HEADS, PAST_LEN, D_HEAD)),
        'cache_swa_v': nrm(ks[3], (DEC_BATCH, DEPTH, SWA_KV_HEADS, PAST_LEN, D_HEAD)),
        'cache_nat_k': nrm(ks[4], (DEC_BATCH, DEPTH, NAT_HEADS, PAST_LEN, D_HEAD)),
        'cache_nat_v': nrm(ks[5], (DEC_BATCH, DEPTH, NAT_HEADS, PAST_LEN, D_HEAD)),
        'state_mlstm_C': nrm(ks[6], (DEC_BATCH, DEPTH, 2, ML_HEADS, D_HEAD, D_HEAD), 0.1),
        'state_mlstm_n': nrm(ks[7], (DEC_BATCH, DEPTH, 2, ML_HEADS, D_HEAD), 0.5),
        'state_mlstm_m': nrm(ks[8], (DEC_BATCH, DEPTH, 2, ML_HEADS)),
        'c': nrm(ks[9], (DEC_BATCH, d)),
        'c_ctx': nrm(ks[10], (d,)),
        'w_ada': nrm(ks[11], (DEPTH, d, 6 * d), 0.5 * d ** -0.5),
        'b_ada': nrm(ks[12], (DEPTH, 6 * d), 0.02),
        'w_in': nrm(ks[13], (DEPTH, d, IN_DIM), d ** -0.5),
        'b_in': nrm(ks[14], (DEPTH, IN_DIM), 0.02),
        'mlstm_fbias': jnp.linspace(3.0, 6.0, ML_HEADS, dtype=jnp.float32) + nrm(ks[15], (DEPTH, 2, ML_HEADS), 0.1),
        'mlstm_norm_g': 1.0 + nrm(ks[16], (DEPTH, ML_W), 0.02),
        'swa_sink': nrm(ks[17], (DEPTH, SWA_HEADS), 0.5),
        'nat_rpb': nrm(ks[18], (DEPTH, NAT_HEADS, 2 * NAT_KH - 1, 2 * NAT_KW - 1), 0.1),
        'w_out': nrm(ks[19], (DEPTH, MIX_W, d), DN_BETA * MIX_W ** -0.5),
        'ln1_g': 1.0 + nrm(ks[20], (DEPTH, d), 0.02),
        'ln1_b': nrm(ks[21], (DEPTH, d), 0.02),
        'w_mlp1': nrm(ks[22], (DEPTH, d, D_FF), d ** -0.5),
        'w_mlp2': nrm(ks[23], (DEPTH, D_FF, d), DN_BETA * D_FF ** -0.5),
        'ln2_g': 1.0 + nrm(ks[24], (DEPTH, d), 0.02),
        'ln2_b': nrm(ks[25], (DEPTH, d), 0.02),
    }


def reference(x_prompt, x_sample, cache_swa_k, cache_swa_v, cache_nat_k, cache_nat_v,
              state_mlstm_C, state_mlstm_n, state_mlstm_m, c, c_ctx,
              w_ada, b_ada, w_in, b_in, mlstm_fbias, mlstm_norm_g, swa_sink, nat_rpb,
              w_out, ln1_g, ln1_b, w_mlp1, w_mlp2, ln2_g, ln2_b):
    xp = x_prompt
    xs = x_sample
    ks_l, vs_l, kn_l, vn_l, cs_l, ns_l, ms_l = [], [], [], [], [], [], []
    for l in range(DEPTH):
        xp, (k_swa, v_swa, k_nat, v_nat, st_c, st_n, st_m) = _context_layer(
            xp, c_ctx, w_ada[l], b_ada[l], w_in[l], b_in[l], mlstm_fbias[l], mlstm_norm_g[l],
            swa_sink[l], w_out[l], ln1_g[l], ln1_b[l], w_mlp1[l], w_mlp2[l], ln2_g[l], ln2_b[l])
        ks_l.append(k_swa)
        vs_l.append(v_swa)
        kn_l.append(k_nat)
        vn_l.append(v_nat)
        cs_l.append(st_c)
        ns_l.append(st_n)
        ms_l.append(st_m)
        xs = _latent_layer(
            xs, c, cache_swa_k[:, l], cache_swa_v[:, l], cache_nat_k[:, l], cache_nat_v[:, l],
            state_mlstm_C[:, l], state_mlstm_n[:, l], state_mlstm_m[:, l],
            w_ada[l], b_ada[l], w_in[l], b_in[l], mlstm_fbias[l], mlstm_norm_g[l], swa_sink[l], nat_rpb[l],
            w_out[l], ln1_g[l], ln1_b[l], w_mlp1[l], w_mlp2[l], ln2_g[l], ln2_b[l])
    new_swa_k = jnp.stack(ks_l, axis=1)
    new_swa_v = jnp.stack(vs_l, axis=1)
    new_nat_k = jnp.stack(kn_l, axis=1)
    new_nat_v = jnp.stack(vn_l, axis=1)
    new_mlstm_C = jnp.stack(cs_l, axis=1)
    new_mlstm_n = jnp.stack(ns_l, axis=1)
    new_mlstm_m = jnp.stack(ms_l, axis=1)
    return (xp, xs, new_swa_k, new_swa_v, new_nat_k, new_nat_v, new_mlstm_C, new_mlstm_n, new_mlstm_m)
```

```cpp
#include <hip/hip_runtime.h>
#include <cstdio>
#include <cstdint>

#ifndef PROBE_DUP
#define PROBE_DUP 0
#endif
#ifndef MK_N_LAUNCHES
#define MK_N_LAUNCHES 1
#endif

#define DI __device__ __forceinline__
#define LAS __attribute__((address_space(3)))
#define GAS __attribute__((address_space(1)))
typedef unsigned short bf16_t;
typedef short bf16x8 __attribute__((ext_vector_type(8)));
typedef short s16x4 __attribute__((ext_vector_type(4)));
typedef float f32x4 __attribute__((ext_vector_type(4)));
typedef float f32x16 __attribute__((ext_vector_type(16)));
typedef float f32x4u __attribute__((ext_vector_type(4), aligned(4)));
typedef unsigned u32x4 __attribute__((ext_vector_type(4)));
typedef unsigned u32x2 __attribute__((ext_vector_type(2)));
typedef float f32x2_t __attribute__((ext_vector_type(2)));
typedef __bf16 bf16x2_t __attribute__((ext_vector_type(2)));

constexpr int DM = 1024, CTX_B = 16, CTX_T = 256, LAT_B = 8, LAT_T = 1024, DEPTH = 4, PAST = 512;
constexpr int MCTX = CTX_B * CTX_T, MLAT = LAT_B * LAT_T, MTOK = MCTX + MLAT;
constexpr int NZ = 2048, NVT = 768, NIN = NZ + NVT, DFF = 4096, IN_DIM = 2832;
constexpr float LN_EPS = 1e-5f;
constexpr float DN_ALPHA = 1.681792830507429f;
constexpr float LOG2E = 1.4426950408889634f;
constexpr float QSCALE = 0.125f * LOG2E;
constexpr int ZC_MQ = 0, ZC_MK = 256, ZC_MO = 512, ZC_SQ = 768, ZC_SK = 1152, ZC_NQ = 1280, ZC_NK = 1664;
constexpr int VR_MV = 0, VR_SV = 256, VR_NV = 384;
constexpr size_t O_Y = 0, O_SWAK = 12582912, O_SWAV = 14680064, O_NATK = 16777216, O_NATV = 23068672, O_MC = 29360128, O_MN = 31457280, O_MM = 31490048;

constexpr size_t CTL_BYTES = 1u << 20;
constexpr size_t SZ_WIN_L = (size_t)NIN * DM * 2, SZ_WOUT_L = (size_t)DM * DM * 2, SZ_W1_L = (size_t)DFF * DM * 2;
constexpr size_t WS_WIN = CTL_BYTES;
constexpr size_t WS_WOUT = WS_WIN + 4 * SZ_WIN_L;
constexpr size_t WS_W1 = WS_WOUT + 4 * SZ_WOUT_L;
constexpr size_t WS_W2 = WS_W1 + 4 * SZ_W1_L;
constexpr size_t WS_BINZ = WS_W2 + 4 * SZ_W1_L;
constexpr size_t WS_WGT = WS_BINZ + 45056;
constexpr size_t WS_BG = WS_WGT + 262144;
constexpr size_t WS_MODS = WS_BG + 256;
constexpr size_t WS_ROPE = WS_MODS + 884736;
constexpr size_t WS_RPB2 = WS_ROPE + 8192;
constexpr int RPB_STRIDE = 544, RPB_OFF = 32;
constexpr size_t WS_CKS = WS_RPB2 + 52224;
constexpr size_t WS_CVS = WS_CKS + 4194304;
constexpr size_t WS_CKN = WS_CVS + 4194304;
constexpr size_t WS_CVN = WS_CKN + 12582912;
constexpr size_t WS_H = WS_CVN + 12582912;
constexpr size_t WS_HM = WS_H + (size_t)MTOK * DM * 2;
constexpr size_t WS_GATES = WS_HM + (size_t)MTOK * DM * 2;
constexpr size_t WS_X1 = WS_GATES + (size_t)MTOK * 16 * 4;
constexpr size_t WS_OV = WS_X1 + (size_t)MTOK * DM * 4;
constexpr size_t OV_Z = 0;
constexpr size_t OV_VT = OV_Z + (size_t)MTOK * NZ * 2;
constexpr size_t OV_MIX = OV_VT + (size_t)NVT * MTOK * 2;
constexpr size_t OV_U = OV_MIX + (size_t)MTOK * DM * 2;
constexpr size_t OV_CST = OV_U + (size_t)1536 * 4096 * 4;
constexpr size_t OV_NN = OV_CST + (size_t)1536 * 4096 * 2;
constexpr size_t OV_NST = OV_NN + (size_t)1536 * 64 * 4;
constexpr size_t OV_SC = OV_NST + (size_t)1536 * 64 * 4;
constexpr size_t OV_END = OV_SC + (size_t)1536 * 16;
constexpr size_t OV_H1 = 0;
constexpr size_t WS_END = WS_OV + (OV_END > (size_t)MTOK * DFF * 2 ? OV_END : (size_t)MTOK * DFF * 2);
static_assert(WS_BINZ % 256 == 0 && WS_WGT % 256 == 0 && WS_MODS % 256 == 0 && WS_ROPE % 256 == 0 && WS_RPB2 % 256 == 0 && WS_CKS % 256 == 0 && WS_H % 256 == 0 && WS_OV % 256 == 0, "ws align");
constexpr int CW_BAR = 4096, CW_Q = 16384;

constexpr int RING_BYTES = 131072;
constexpr int LDSCTL_OFF = RING_BYTES, MISC_OFF = LDSCTL_OFF + 320;
constexpr int LDS_BYTES = 147456;

DI float bf2f(bf16_t u) { return __uint_as_float(((unsigned)u) << 16); }
DI float bfs2f(short u) { return __uint_as_float(((unsigned)(unsigned short)u) << 16); }
DI unsigned pk2(float lo, float hi) { f32x2_t v = {lo, hi}; bf16x2_t b = __builtin_convertvector(v, bf16x2_t); return __builtin_bit_cast(unsigned, b); }
DI int crow(int r, int hi) { return (r & 3) + 8 * (r >> 2) + 4 * hi; }
DI float swap_max(float v) { auto rr = __builtin_amdgcn_permlane32_swap(__float_as_uint(v), __float_as_uint(v), false, false); return fmaxf(__uint_as_float(rr[0]), __uint_as_float(rr[1])); }
DI float swap_sum(float v) { auto rr = __builtin_amdgcn_permlane32_swap(__float_as_uint(v), __float_as_uint(v), false, false); return __uint_as_float(rr[0]) + __uint_as_float(rr[1]); }
DI float shfl_f(float v, int src) { return __int_as_float(__builtin_amdgcn_ds_bpermute(src << 2, __float_as_int(v))); }
DI float swap_other(float v, int h2) { auto rr = __builtin_amdgcn_permlane32_swap(__float_as_uint(v), __float_as_uint(v), false, false); return __uint_as_float(h2 ? rr[0] : rr[1]); }
DI float wave_sum(float v, int lane) {
#pragma unroll
    for (int o = 1; o < 32; o <<= 1) v += shfl_f(v, lane ^ o);
    return swap_sum(v);
}
DI float fexp(float x) { return __builtin_amdgcn_exp2f(x * LOG2E); }
#define MFMA32(a, b, c) __builtin_amdgcn_mfma_f32_32x32x16_bf16((a), (b), (c), 0, 0, 0)
#define LDS_WAIT() asm volatile("s_waitcnt lgkmcnt(0)" ::: "memory")
#define VM_WAIT() asm volatile("s_waitcnt vmcnt(0)" ::: "memory")

namespace pg8 {
constexpr int BM = 256, BK = 64, HALF = 128, HTB = HALF * BK * 2, STAGE_BYTES = 8 * HTB, NXCD = 8, WGM = 8;
__host__ __device__ __forceinline__ int lds_byte(int r, int c) { const int st = (r >> 4) * 2 + (c >> 5), rr = r & 15, cc = c & 31, ob = rr * 64 + cc * 2; return st * 1024 + (ob ^ (((ob >> 9) & 1) << 5)); }
__host__ __device__ __forceinline__ void stage_rc(int b, int& R, int& C) { const int st = b / 1024, sb = b % 1024, swz = sb ^ (((sb >> 9) & 1) << 5); R = (st >> 1) * 16 + swz / 64; C = (st & 1) * 32 + (swz % 64) / 2; }
__host__ __device__ __forceinline__ int perm32(int rho) { const int n = rho >> 4, i = rho & 15; return 8 * (i >> 2) + 4 * n + (i & 3); }
struct Unit { int pm, pn; };
struct StaticOrder {
    int nM, nN, nwg, G, c;
    DI void init(int nM_, int nN_, int G_, int c_) { nM = nM_; nN = nN_; nwg = nM * nN; G = G_; c = c_; }
    DI bool next(int i, Unit& u) const {
        const long L = (long)i * G + c; if (L >= nwg) return false;
        int wgid = (int)L; { const int q = nwg / NXCD, r = nwg % NXCD, xcd = wgid % NXCD, off = wgid / NXCD; wgid = (xcd < r ? xcd * (q + 1) : r * (q + 1) + (xcd - r) * q) + off; }
        const int nig = WGM * nN, gid = wgid / nig, fm = gid * WGM, gsz = (nM - fm) < WGM ? (nM - fm) : WGM;
        u.pm = fm + ((wgid % nig) % gsz); u.pn = (wgid % nig) / gsz; return true;
    }
};
enum { EPI_G1 = 0, EPI_RELU2 = 1, EPI_RES = 2 };
struct Epi {
    int kind;
    bf16_t* Z; bf16_t* VT; const float* binz; const float* rope;
    bf16_t* H1;
    const float* xres_ctx; const float* xres_lat; float* out; const float* gvec;
};
struct Gemm { const bf16_t* A; const bf16_t* Bt; int K; int nM, nN, nNz; bool perm; };

DI void epilogue(const Epi& E, const f32x4 (&acc)[2][2][4][2], const Unit& u, int wr, int wc, int fr, int fq) {
    if (E.kind == EPI_G1) {
        if (u.pn < 8) {
            const int row0 = u.pm * BM + wr * 64 + fr, col0 = u.pn * BM + wc * 32 + 8 * fq;
            const bool do_rope = (u.pn == 3 || u.pn == 4) && (u.pm >= 16);
            f32x4 bv[2][2];
#pragma unroll
            for (int bj = 0; bj < 2; ++bj)
#pragma unroll
                for (int n = 0; n < 2; ++n) bv[bj][n] = *(const f32x4*)(E.binz + col0 + bj * HALF + 4 * n);
#pragma unroll
            for (int ai = 0; ai < 2; ++ai)
#pragma unroll
                for (int m = 0; m < 4; ++m) {
                    const int row = row0 + ai * HALF + m * 16;
                    bf16_t* rowp = E.Z + (size_t)row * NZ + col0;
                    f32x4 cs[4];
                    if (do_rope) {
                        const int t = (row - MCTX) & (LAT_T - 1);
                        const int pos = (wc & 1) ? (t & 63) : (t >> 6);
                        const float* rp = E.rope + (pos * 16 + 8 * (fq & 1)) * 2;
#pragma unroll
                        for (int k = 0; k < 4; ++k) cs[k] = *(const f32x4*)(rp + 4 * k);
                    }
#pragma unroll
                    for (int bj = 0; bj < 2; ++bj) {
                        f32x4 v0 = acc[ai][bj][m][0] + bv[bj][0], v1 = acc[ai][bj][m][1] + bv[bj][1];
                        if (do_rope) {
                            f32x4 p0, p1;
#pragma unroll
                            for (int e = 0; e < 4; ++e) { p0[e] = swap_other(v0[e], fq >> 1); p1[e] = swap_other(v1[e], fq >> 1); }
                            const float sg = (fq < 2) ? -1.f : 1.f;
                            f32x4 o0, o1;
                            o0[0] = v0[0] * cs[0][0] + sg * p0[0] * cs[0][1]; o0[1] = v0[1] * cs[0][2] + sg * p0[1] * cs[0][3];
                            o0[2] = v0[2] * cs[1][0] + sg * p0[2] * cs[1][1]; o0[3] = v0[3] * cs[1][2] + sg * p0[3] * cs[1][3];
                            o1[0] = v1[0] * cs[2][0] + sg * p1[0] * cs[2][1]; o1[1] = v1[1] * cs[2][2] + sg * p1[1] * cs[2][3];
                            o1[2] = v1[2] * cs[3][0] + sg * p1[2] * cs[3][1]; o1[3] = v1[3] * cs[3][2] + sg * p1[3] * cs[3][3];
                            v0 = o0; v1 = o1;
                        }
                        u32x4 w; w.x = pk2(v0[0], v0[1]); w.y = pk2(v0[2], v0[3]); w.z = pk2(v1[0], v1[1]); w.w = pk2(v1[2], v1[3]);
                        *(u32x4*)(rowp + bj * HALF) = w;
                    }
                }
        } else {
            const int f0 = (u.pn - 8) * BM + wr * 64 + fr, col0 = u.pm * BM + wc * 32 + 8 * fq;
#pragma unroll
            for (int ai = 0; ai < 2; ++ai)
#pragma unroll
                for (int m = 0; m < 4; ++m) {
                    const int f = f0 + ai * HALF + m * 16;
                    const float b = E.binz[NZ + f];
                    bf16_t* rowp = E.VT + (size_t)f * MTOK + col0;
#pragma unroll
                    for (int bj = 0; bj < 2; ++bj) {
                        const f32x4 v0 = acc[ai][bj][m][0] + b, v1 = acc[ai][bj][m][1] + b;
                        u32x4 w; w.x = pk2(v0[0], v0[1]); w.y = pk2(v0[2], v0[3]); w.z = pk2(v1[0], v1[1]); w.w = pk2(v1[2], v1[3]);
                        *(u32x4*)(rowp + bj * HALF) = w;
                    }
                }
        }
    } else if (E.kind == EPI_RELU2) {
        const int row0 = u.pm * BM + wr * 64 + fr, col0 = u.pn * BM + wc * 32 + 8 * fq;
#pragma unroll
        for (int ai = 0; ai < 2; ++ai)
#pragma unroll
            for (int m = 0; m < 4; ++m) {
                bf16_t* rowp = E.H1 + (size_t)(row0 + ai * HALF + m * 16) * DFF + col0;
#pragma unroll
                for (int bj = 0; bj < 2; ++bj) {
                    f32x4 v0 = acc[ai][bj][m][0], v1 = acc[ai][bj][m][1];
#pragma unroll
                    for (int e = 0; e < 4; ++e) { const float a = fmaxf(v0[e], 0.f), b = fmaxf(v1[e], 0.f); v0[e] = a * a; v1[e] = b * b; }
                    u32x4 w; w.x = pk2(v0[0], v0[1]); w.y = pk2(v0[2], v0[3]); w.z = pk2(v1[0], v1[1]); w.w = pk2(v1[2], v1[3]);
                    *(u32x4*)(rowp + bj * HALF) = w;
                }
            }
    } else {
        const int row0 = u.pm * BM + wr * 64 + fr, col0 = u.pn * BM + wc * 32 + 4 * fq;
        const int bidx = (u.pm < 16) ? 0 : 1 + ((u.pm - 16) >> 2);
        const float* gv = E.gvec + (size_t)bidx * 6144 + col0;
        f32x4 g[2][2];
#pragma unroll
        for (int bj = 0; bj < 2; ++bj)
#pragma unroll
            for (int n = 0; n < 2; ++n) g[bj][n] = *(const f32x4*)(gv + bj * HALF + n * 16);
#pragma unroll
        for (int ai = 0; ai < 2; ++ai)
#pragma unroll
            for (int m = 0; m < 4; ++m) {
                const int row = row0 + ai * HALF + m * 16;
                const float* xr = (row < MCTX ? E.xres_ctx + (size_t)row * DM : E.xres_lat + (size_t)(row - MCTX) * DM) + col0;
                float* op = E.out + (size_t)row * DM + col0;
#pragma unroll
                for (int bj = 0; bj < 2; ++bj)
#pragma unroll
                    for (int n = 0; n < 2; ++n) {
                        const f32x4 xv = *(const f32x4*)(xr + bj * HALF + n * 16);
                        *(f32x4*)(op + bj * HALF + n * 16) = xv * DN_ALPHA + g[bj][n] * acc[ai][bj][m][n];
                    }
            }
    }
}

DI void gemm_phase(LAS unsigned char* lds, const Gemm g, const StaticOrder& S, const Epi& E, const int tid) {
    const int wid = __builtin_amdgcn_readfirstlane(tid >> 6), lane = tid & 63, wr = wid >> 2, wc = wid & 3, fr = lane & 15, fq = lane >> 4;
    const int K = g.K, nt = K / BK;
    unsigned voffA[2], voffB[2];
#pragma unroll
    for (int i = 0; i < 2; ++i) { int R, C; stage_rc(tid * 16 + i * 8192, R, C); const int Rb = g.perm ? ((R & ~31) + perm32(R & 31)) : R;
        voffA[i] = (unsigned)(R * K + C) * 2u; voffB[i] = (unsigned)(Rb * K + C) * 2u; }
    const size_t kstep = (size_t)(BK * 2);
    const size_t hstep = (size_t)HALF * K * 2;
    const size_t tstep = 2 * hstep;
    const unsigned ldsw = (unsigned)wid * 1024u;
    const int aoff = lds_byte(wr * 64 + fr, fq * 8), boff = lds_byte(wc * 32 + fr, fq * 8);
#define PG8_SA(b, h) (((b) * 2 + (h)) * HTB)
#define PG8_SB(b, h) ((4 + (b) * 2 + (h)) * HTB)
#define PG8_STAGE(bufoff, gbase, voff) do { _Pragma("unroll") for (int _i = 0; _i < 2; ++_i) \
        __builtin_amdgcn_global_load_lds((const unsigned*)((const char*)(gbase) + (voff)[_i]), (LAS unsigned*)(lds + (bufoff) + ldsw + _i * 8192), 16, 0, 0); } while (0)
#define PG8_LDA(dst, b, h) do { _Pragma("unroll") for (int m = 0; m < 4; ++m) _Pragma("unroll") for (int k = 0; k < 2; ++k) dst[m][k] = *(const LAS bf16x8*)(lds + PG8_SA(b, h) + aoff + m * 2048 + k * 1024); } while (0)
#define PG8_LDB(dst, b, h) do { _Pragma("unroll") for (int n = 0; n < 2; ++n) _Pragma("unroll") for (int k = 0; k < 2; ++k) dst[n][k] = *(const LAS bf16x8*)(lds + PG8_SB(b, h) + boff + n * 2048 + k * 1024); } while (0)
#define PG8_MMA(ai, bj, At, Bt) do { __builtin_amdgcn_s_setprio(1); _Pragma("unroll") for (int m = 0; m < 4; ++m) _Pragma("unroll") for (int n = 0; n < 2; ++n) _Pragma("unroll") for (int k = 0; k < 2; ++k) \
        acc[ai][bj][m][n] = __builtin_amdgcn_mfma_f32_16x16x32_bf16(Bt[n][k], At[m][k], acc[ai][bj][m][n], 0, 0, 0); __builtin_amdgcn_s_setprio(0); } while (0)
#define PG8_WAIT_V(n) asm volatile("s_waitcnt vmcnt(" #n ")" ::: "memory")
#define PG8_WAIT_L(n) asm volatile("s_waitcnt lgkmcnt(" #n ")" ::: "memory")
#define PG8_BAR __builtin_amdgcn_s_barrier()
#define PG8_SCHED __builtin_amdgcn_sched_barrier(0)
#define PG8_PTRS(u, pa, pb) do { const bool sw_ = (u).pn >= g.nNz; const char* a_ = (const char*)g.A + (size_t)(u).pm * tstep; const char* b_ = (const char*)g.Bt + (size_t)(u).pn * tstep; pa = sw_ ? b_ : a_; pb = sw_ ? a_ : b_; } while (0)
    Unit cur, nxt; int ui = 0;
    if (!S.next(0, cur)) return;
    f32x4 acc[2][2][4][2];
#pragma unroll
    for (int a = 0; a < 2; ++a)
#pragma unroll
        for (int b = 0; b < 2; ++b)
#pragma unroll
            for (int m = 0; m < 4; ++m)
#pragma unroll
                for (int n = 0; n < 2; ++n) acc[a][b][m][n] = (f32x4){0.f, 0.f, 0.f, 0.f};
    bf16x8 At[4][2], B0[2][2], B1[2][2];
    const char* cA; const char* cB; PG8_PTRS(cur, cA, cB);
    PG8_STAGE(PG8_SB(0, 0), cB, voffB); PG8_STAGE(PG8_SB(0, 1), cB + hstep, voffB); PG8_STAGE(PG8_SA(0, 0), cA, voffA); PG8_STAGE(PG8_SA(0, 1), cA + hstep, voffA);
    if (wr == 1) PG8_BAR;
    PG8_WAIT_V(2); PG8_BAR;
    PG8_STAGE(PG8_SB(1, 0), cB + kstep, voffB); PG8_STAGE(PG8_SA(1, 0), cA + kstep, voffA); PG8_STAGE(PG8_SB(1, 1), cB + hstep + kstep, voffB);
    PG8_WAIT_V(6); PG8_BAR;
    for (;;) {
        const bool has_next = S.next(ui + 1, nxt);
        const char* nA = cA; const char* nB = cB; if (has_next) PG8_PTRS(nxt, nA, nB);
        for (int t = 0; t < nt; t += 2) {
            const bool last = (t == nt - 2);
            const char* a1 = cA + (size_t)(t + 1) * kstep;
            const char* a2 = last ? nA : cA + (size_t)(t + 2) * kstep; const char* b2 = last ? nB : cB + (size_t)(t + 2) * kstep;
            const char* a3 = a2 + kstep; const char* b3 = b2 + kstep;
            PG8_LDB(B0, 0, 0); PG8_LDB(B1, 0, 1); PG8_SCHED; PG8_LDA(At, 0, 0); PG8_STAGE(PG8_SA(1, 1), a1 + hstep, voffA);
            PG8_WAIT_V(8); PG8_WAIT_L(0); PG8_BAR; PG8_MMA(0, 0, At, B0); PG8_MMA(0, 1, At, B1); PG8_BAR; PG8_SCHED;
            PG8_LDA(At, 0, 1); PG8_STAGE(PG8_SB(0, 0), b2, voffB); PG8_STAGE(PG8_SB(0, 1), b2 + hstep, voffB); PG8_STAGE(PG8_SA(0, 0), a2, voffA);
            PG8_WAIT_V(8); PG8_WAIT_L(0); PG8_BAR; PG8_MMA(1, 0, At, B0); PG8_MMA(1, 1, At, B1); PG8_BAR; PG8_SCHED;
            PG8_LDB(B0, 1, 0); PG8_LDB(B1, 1, 1); PG8_SCHED; PG8_LDA(At, 1, 0); PG8_STAGE(PG8_SA(0, 1), a2 + hstep, voffA);
            PG8_WAIT_V(8); PG8_WAIT_L(0); PG8_BAR; PG8_MMA(0, 0, At, B0); PG8_MMA(0, 1, At, B1); PG8_BAR; PG8_SCHED;
            PG8_LDA(At, 1, 1); PG8_STAGE(PG8_SB(1, 0), b3, voffB); PG8_STAGE(PG8_SB(1, 1), b3 + hstep, voffB); PG8_STAGE(PG8_SA(1, 0), a3, voffA);
            PG8_WAIT_V(8); PG8_WAIT_L(0); PG8_BAR; PG8_MMA(1, 0, At, B0); PG8_MMA(1, 1, At, B1); PG8_BAR; PG8_SCHED;
        }
        if (wr == 0) PG8_BAR;
        epilogue(E, acc, cur, wr, wc, fr, fq);
        if (!has_next) break;
#pragma unroll
        for (int a = 0; a < 2; ++a)
#pragma unroll
            for (int b = 0; b < 2; ++b)
#pragma unroll
                for (int m = 0; m < 4; ++m)
#pragma unroll
                    for (int n = 0; n < 2; ++n) acc[a][b][m][n] = (f32x4){0.f, 0.f, 0.f, 0.f};
        cur = nxt; cA = nA; cB = nB; ++ui;
        if (wr == 1) PG8_BAR;
    }
    PG8_WAIT_V(0);
    PG8_BAR;
#undef PG8_SA
#undef PG8_SB
#undef PG8_STAGE
#undef PG8_LDA
#undef PG8_LDB
#undef PG8_MMA
#undef PG8_WAIT_V
#undef PG8_WAIT_L
#undef PG8_BAR
#undef PG8_SCHED
#undef PG8_PTRS
}
}

typedef GAS unsigned gu32;
#define RLX_AGENT __ATOMIC_RELAXED, __HIP_MEMORY_SCOPE_AGENT
#define XB_TMO      128
#define XB_XCNT(j)  (256  + 64 * (j))
#define XB_XSUB(j)  (1280 + 64 * (j))
#define XB_XGEN(j)  (2304 + 64 * (j))
#define XB_TOP      3328
#define XB_TOPGEN   3392
#define XCD_BAR_WORDS 3456
#define XB_SPIN_CAP (1u << 18)
DI unsigned xb_ld(unsigned* p)              { return __hip_atomic_load(p, __ATOMIC_RELAXED, __HIP_MEMORY_SCOPE_AGENT); }
DI unsigned xb_add(unsigned* p, unsigned v) { return __hip_atomic_fetch_add(p, v, __ATOMIC_RELAXED, __HIP_MEMORY_SCOPE_AGENT); }
DI unsigned xb_xcc_id() { return (unsigned)__builtin_amdgcn_s_getreg((3 << 11) | 20) & 0xFu; }
#define XB_SPIN(cond, bar) do { unsigned _sp = 0; while (cond) { __builtin_amdgcn_s_sleep(1); \
    if ((++_sp & 255u) == 0u) { if (xb_ld(&(bar)[XB_TMO])) break; if (_sp > XB_SPIN_CAP) { atomicAdd(&(bar)[XB_TMO], 1u); break; } } } } while (0)
struct XcdBarrier { unsigned* bar; unsigned x; volatile LAS unsigned* st; };
DI XcdBarrier xcd_barrier_post(unsigned* bar, volatile LAS unsigned* st) {
    XcdBarrier b; b.bar = bar; b.x = xb_xcc_id(); b.st = st;
    if (threadIdx.x == 0) (void)xb_add(&bar[XB_XCNT(b.x)], 1u);
    return b;
}
DI void xcd_barrier_complete(unsigned* bar, unsigned x, unsigned& nloc, unsigned& nx) {
    const unsigned G = gridDim.x * gridDim.y * gridDim.z;
    unsigned sum, cnt, mine, sp = 0u;
    for (;;) {
        sum = 0u; cnt = 0u; mine = 0u;
#pragma unroll 1
        for (unsigned j = 0; j < 16; ++j) { const unsigned c = xb_ld(&bar[XB_XCNT(j)]); sum += c; cnt += (c > 0u) ? 1u : 0u; }
        mine = xb_ld(&bar[XB_XCNT(x)]);
        if (sum == G) break;
        __builtin_amdgcn_s_sleep(1);
        if ((++sp & 255u) == 0u) { if (xb_ld(&bar[XB_TMO])) break; if (sp > XB_SPIN_CAP) { atomicAdd(&bar[XB_TMO], 1u); break; } }
    }
    nloc = mine > 0u ? mine : 1u; nx = cnt > 0u ? cnt : 1u;
}
DI void xcd_barrier(const XcdBarrier& b) {
    asm volatile("s_waitcnt vmcnt(0)" ::: "memory");
    __syncthreads();
    if (threadIdx.x == 0) {
        unsigned* bar = b.bar;
        __builtin_amdgcn_s_waitcnt(0);
        unsigned nloc = b.st[0], nx = b.st[1];
        if (nloc == 0u) { xcd_barrier_complete(bar, b.x, nloc, nx); b.st[0] = nloc; b.st[1] = nx; }
        const unsigned old = xb_add(&bar[XB_XSUB(b.x)], 1u);
        const unsigned gen = old / nloc;
        if (old + 1u == (gen + 1u) * nloc) {
            __builtin_amdgcn_fence(__ATOMIC_RELEASE, "agent");
            asm volatile("s_waitcnt vmcnt(0)" ::: "memory");
            const unsigned og = xb_add(&bar[XB_TOP], 1u);
            const unsigned tg = og / nx;
            if (og + 1u == (tg + 1u) * nx) xb_add(&bar[XB_TOPGEN], 1u);
            else XB_SPIN(xb_ld(&bar[XB_TOPGEN]) == tg, bar);
            __builtin_amdgcn_fence(__ATOMIC_ACQUIRE, "agent");
            xb_add(&bar[XB_XGEN(b.x)], 1u);
            asm volatile("s_waitcnt vmcnt(0)" ::: "memory");
        } else {
            XB_SPIN(xb_ld(&bar[XB_XGEN(b.x)]) == gen, bar);
            __builtin_amdgcn_fence(__ATOMIC_ACQUIRE, "agent");
            asm volatile("s_waitcnt vmcnt(0)" ::: "memory");
        }
    }
    __syncthreads();
}

struct Args { const float* in[26]; float* out; unsigned char* ws; int ph_lo, ph_hi, li, pad; };
enum { I_XP = 0, I_XS, I_CSK, I_CSV, I_CNK, I_CNV, I_SC, I_SN, I_SM, I_C, I_CCTX, I_WADA, I_BADA, I_WIN, I_BIN, I_FB, I_NG, I_SINK, I_RPB, I_WOUT, I_LN1G, I_LN1B, I_W1, I_W2, I_LN2G, I_LN2B };

struct Ctx {
    const Args* a;
    LAS unsigned char* lds;
    unsigned char* ws;
    int tid, lane, wave, G, vcu, phase;
};

DI int win_src_col(int n) {
    if (n < 256) return n;
    if (n < 512) return 256 + (n - 256);
    if (n < 768) return 768 + (n - 512);
    if (n < 1152) return 1040 + (n - 768);
    if (n < 1280) return 1424 + (n - 1152);
    if (n < 1664) return 1680 + (n - 1280);
    if (n < 2048) return 2064 + (n - 1664);
    n -= 2048;
    if (n < 256) return 512 + n;
    if (n < 384) return 1552 + (n - 256);
    return 2448 + (n - 384);
}
DI float win_scale(int n) {
    if (n >= 256 && n < 512) return 0.125f;
    if ((n >= 768 && n < 1152) || (n >= 1280 && n < 1664)) return QSCALE;
    return 1.f;
}

DI void tr_item(const float* src, size_t ld_src, bf16_t* dst, size_t ld_dst, float scale, LAS float* scr, int lane) {
#pragma unroll 8
    for (int i = 0; i < 32; ++i) { const int kk = 2 * i + (lane >> 5); scr[kk * 33 + (lane & 31)] = src[(size_t)kk * ld_src + (lane & 31)] * scale; }
    LDS_WAIT(); asm volatile("" ::: "memory");
    const int c = lane & 7;
#pragma unroll
    for (int j = 0; j < 4; ++j) { const int n = (lane >> 3) + 8 * j; const LAS float* s = scr + (8 * c) * 33 + n;
        u32x4 o; o.x = pk2(s[0 * 33], s[1 * 33]); o.y = pk2(s[2 * 33], s[3 * 33]); o.z = pk2(s[4 * 33], s[5 * 33]); o.w = pk2(s[6 * 33], s[7 * 33]);
        *(u32x4*)(dst + (size_t)n * ld_dst + 8 * c) = o; }
    LDS_WAIT(); asm volatile("" ::: "memory");
}

DI void p0_prologue(const Ctx& X) {
    const Args& A = *X.a;
    unsigned char* ws = X.ws;
    {
        LAS float* sv = (LAS float*)X.lds;
        LAS float* red = (LAS float*)(X.lds + 9 * 1024 * 4);
        for (int e = X.tid; e < 9 * 1024; e += 512) {
            const int j = e >> 10, k = e & 1023;
            const float c = (j == 0) ? A.in[I_CCTX][k] : A.in[I_C][(j - 1) * 1024 + k];
            sv[e] = c / (1.f + fexp(-c));
        }
        __syncthreads();
        float* MODS = (float*)(ws + WS_MODS);
        for (int u = X.vcu; u < DEPTH * 96; u += X.G) {
            const int l = u / 96, cb = u % 96;
            const float* wp = A.in[I_WADA] + (size_t)l * 1024 * 6144 + (size_t)(X.wave * 128) * 6144 + cb * 64 + X.lane;
            float acc[9];
#pragma unroll
            for (int j = 0; j < 9; ++j) acc[j] = 0.f;
            for (int k0 = 0; k0 < 128; k0 += 8) {
                float wv[8];
#pragma unroll
                for (int kk = 0; kk < 8; ++kk) wv[kk] = wp[(size_t)(k0 + kk) * 6144];
#pragma unroll
                for (int kk = 0; kk < 8; ++kk)
#pragma unroll
                    for (int j = 0; j < 9; ++j) acc[j] += sv[j * 1024 + X.wave * 128 + k0 + kk] * wv[kk];
            }
#pragma unroll
            for (int j = 0; j < 9; ++j) red[(X.wave * 9 + j) * 64 + X.lane] = acc[j];
            __syncthreads();
            for (int e = X.tid; e < 576; e += 512) {
                const int j = e >> 6, c = e & 63; float s = 0.f;
#pragma unroll
                for (int w = 0; w < 8; ++w) s += red[(w * 9 + j) * 64 + c];
                MODS[((size_t)l * 9 + j) * 6144 + cb * 64 + c] = s + A.in[I_BADA][l * 6144 + cb * 64 + c];
            }
            __syncthreads();
        }
        __syncthreads();
    }
    {
        LAS float* scr = (LAS float*)(X.lds + X.wave * 16384);
        const int gw = X.vcu * 8 + X.wave, NGW = X.G * 8;
        constexpr int I_IN = 16 * 88, I_OUT = 16 * 32, I_1 = 16 * 128, I_2 = 64 * 32, I_L = I_IN + I_OUT + I_1 + I_2;
        constexpr int I_W = DEPTH * I_L, I_CS = 64 * 16, I_CN = 192 * 16, I_TOT = I_W + I_CS + I_CN;
        for (int it = gw; it < I_TOT; it += NGW) {
            if (it < I_W) {
                const int l = it / I_L; int r = it % I_L;
                if (r < I_IN) { const int kb = r / 88, nb = r % 88, n0 = nb * 32;
                    tr_item(A.in[I_WIN] + (size_t)l * 1024 * IN_DIM + (size_t)(kb * 64) * IN_DIM + win_src_col(n0), IN_DIM,
                            (bf16_t*)(ws + WS_WIN + l * SZ_WIN_L) + (size_t)n0 * DM + kb * 64, DM, win_scale(n0), scr, X.lane); continue; }
                r -= I_IN;
                if (r < I_OUT) { const int kb = r / 32, nb = r % 32;
                    tr_item(A.in[I_WOUT] + (size_t)l * DM * DM + (size_t)(kb * 64) * DM + nb * 32, DM,
                            (bf16_t*)(ws + WS_WOUT + l * SZ_WOUT_L) + (size_t)(nb * 32) * DM + kb * 64, DM, 1.f, scr, X.lane); continue; }
                r -= I_OUT;
                if (r < I_1) { const int kb = r / 128, nb = r % 128;
                    tr_item(A.in[I_W1] + (size_t)l * DM * DFF + (size_t)(kb * 64) * DFF + nb * 32, DFF,
                            (bf16_t*)(ws + WS_W1 + l * SZ_W1_L) + (size_t)(nb * 32) * DM + kb * 64, DM, 1.f, scr, X.lane); continue; }
                r -= I_1;
                { const int kb = r / 32, nb = r % 32;
                    tr_item(A.in[I_W2] + (size_t)l * DFF * DM + (size_t)(kb * 64) * DM + nb * 32, DM,
                            (bf16_t*)(ws + WS_W2 + l * SZ_W1_L) + (size_t)(nb * 32) * DFF + kb * 64, DFF, 1.f, scr, X.lane); }
            } else if (it < I_W + I_CS) {
                const int r = it - I_W, mat = r / 16, sub = r % 16, kb = sub / 2, nb = sub % 2;
                tr_item(A.in[I_CSV] + (size_t)mat * 512 * 64 + (size_t)(kb * 64) * 64 + nb * 32, 64,
                        (bf16_t*)(ws + WS_CVS) + (size_t)mat * 64 * 512 + (size_t)(nb * 32) * 512 + kb * 64, 512, 1.f, scr, X.lane);
            } else {
                const int r = it - I_W - I_CS, mat = r / 16, sub = r % 16, kb = sub / 2, nb = sub % 2;
                tr_item(A.in[I_CNV] + (size_t)mat * 512 * 64 + (size_t)(kb * 64) * 64 + nb * 32, 64,
                        (bf16_t*)(ws + WS_CVN) + (size_t)mat * 64 * 512 + (size_t)(nb * 32) * 512 + kb * 64, 512, 1.f, scr, X.lane);
            }
        }
    }
    {
        const size_t gt = (size_t)X.vcu * 512 + X.tid, NT = (size_t)X.G * 512;
        for (size_t e = gt; e < (size_t)2097152 / 8; e += NT) {
            const f32x4 a = *(const f32x4*)(A.in[I_CSK] + e * 8), b = *(const f32x4*)(A.in[I_CSK] + e * 8 + 4);
            u32x4 o; o.x = pk2(a[0], a[1]); o.y = pk2(a[2], a[3]); o.z = pk2(b[0], b[1]); o.w = pk2(b[2], b[3]);
            *(u32x4*)((bf16_t*)(ws + WS_CKS) + e * 8) = o;
        }
        for (size_t e = gt; e < (size_t)6291456 / 8; e += NT) {
            const f32x4 a = *(const f32x4*)(A.in[I_CNK] + e * 8), b = *(const f32x4*)(A.in[I_CNK] + e * 8 + 4);
            u32x4 o; o.x = pk2(a[0], a[1]); o.y = pk2(a[2], a[3]); o.z = pk2(b[0], b[1]); o.w = pk2(b[2], b[3]);
            *(u32x4*)((bf16_t*)(ws + WS_CKN) + e * 8) = o;
        }
        float* binz = (float*)(ws + WS_BINZ);
        for (size_t e = gt; e < (size_t)DEPTH * NIN; e += NT) { const int l = (int)(e / NIN), n = (int)(e % NIN); binz[e] = A.in[I_BIN][l * IN_DIM + win_src_col(n)] * win_scale(n); }
        float* wgt = (float*)(ws + WS_WGT);
        for (size_t e = gt; e < (size_t)DEPTH * 16 * 1024; e += NT) { const int l = (int)(e >> 14), t = (int)((e >> 10) & 15), k = (int)(e & 1023); wgt[e] = A.in[I_WIN][(size_t)l * 1024 * IN_DIM + (size_t)k * IN_DIM + 1024 + t]; }
        float* bg = (float*)(ws + WS_BG);
        for (size_t e = gt; e < (size_t)DEPTH * 16; e += NT) bg[e] = A.in[I_BIN][(e >> 4) * IN_DIM + 1024 + (e & 15)];
        float* rope = (float*)(ws + WS_ROPE);
        for (size_t e = gt; e < 64 * 16; e += NT) { const int pos = (int)(e >> 4), i = (int)(e & 15);
            const float fr = __builtin_amdgcn_exp2f(-(float)i * (13.287712379549449f / 16.f)); const float rev = __builtin_amdgcn_fractf((float)pos * fr * 0.15915494309189535f);
            rope[2 * e] = __builtin_amdgcn_cosf(rev); rope[2 * e + 1] = __builtin_amdgcn_sinf(rev); }
        float* rpb2 = (float*)(ws + WS_RPB2);
        for (size_t e = gt; e < (size_t)DEPTH * 6 * RPB_STRIDE; e += NT) { const int tb_ = (int)(e / RPB_STRIDE), o_ = (int)(e % RPB_STRIDE) - RPB_OFF; rpb2[e] = (o_ >= 0 && o_ < 465) ? A.in[I_RPB][tb_ * 465 + o_] * LOG2E : 0.f; }
    }
}

DI void row_pass(const Ctx& X, int mode, int l) {
    const Args& A = *X.a; unsigned char* ws = X.ws;
    const int lg = (mode == 2) ? l + 1 : l;
    const bool do_gates = (mode == 0) || (mode == 2 && l < DEPTH - 1);
    LAS float* wg = (LAS float*)X.lds;
    if (do_gates) {
        const float* wgt = (const float*)(ws + WS_WGT) + (size_t)lg * 16 * 1024;
        for (int e = X.tid; e < 16 * 1024 / 4; e += 512) *(LAS f32x4*)(wg + 4 * e) = *(const f32x4*)(wgt + 4 * e);
    }
    __syncthreads();
    const float* MODS = (const float*)(ws + WS_MODS);
    float* X1 = (float*)(ws + WS_X1);
    float* XO = A.out + O_Y;
    bf16_t* Hd = (bf16_t*)(ws + (mode == 1 ? WS_HM : WS_H));
    float* GT = (float*)(ws + WS_GATES);
    const float* lng = (mode == 1) ? A.in[I_LN1G] + l * DM : A.in[I_LN2G] + l * DM;
    const float* lnb = (mode == 1) ? A.in[I_LN1B] + l * DM : A.in[I_LN2B] + l * DM;
    const int gw = X.vcu * 8 + X.wave, NGW = X.G * 8;
    for (int row = gw; row < MTOK; row += NGW) {
        const int bidx = (row < MCTX) ? 0 : 1 + ((row - MCTX) >> 10);
        const float* src = (mode == 0) ? (row < MCTX ? A.in[I_XP] + (size_t)row * DM : A.in[I_XS] + (size_t)(row - MCTX) * DM) : X1 + (size_t)row * DM;
        f32x4 v[4];
#pragma unroll
        for (int j = 0; j < 4; ++j) v[j] = *(const f32x4*)(src + 256 * j + 4 * X.lane);
        if (mode != 0) {
            float s = 0.f;
#pragma unroll
            for (int j = 0; j < 4; ++j) s += (v[j][0] + v[j][1]) + (v[j][2] + v[j][3]);
            const float mean = wave_sum(s, X.lane) * (1.f / DM); float s2 = 0.f;
#pragma unroll
            for (int j = 0; j < 4; ++j) { v[j] = v[j] - mean; s2 += (v[j][0] * v[j][0] + v[j][1] * v[j][1]) + (v[j][2] * v[j][2] + v[j][3] * v[j][3]); }
            const float rstd = 1.f / sqrtf(wave_sum(s2, X.lane) * (1.f / DM) + LN_EPS);
            float* dst = (mode == 1) ? X1 + (size_t)row * DM : XO + (size_t)row * DM;
#pragma unroll
            for (int j = 0; j < 4; ++j) {
                const f32x4 g = *(const f32x4*)(lng + 256 * j + 4 * X.lane), b = *(const f32x4*)(lnb + 256 * j + 4 * X.lane);
                v[j] = v[j] * rstd * g + b;
                *(f32x4*)(dst + 256 * j + 4 * X.lane) = v[j];
            }
        }
        if (mode == 2 && l == DEPTH - 1) continue;
        const float* md = MODS + ((size_t)lg * 9 + bidx) * 6144 + (mode == 1 ? 3072 : 0);
        f32x4 h[4];
#pragma unroll
        for (int j = 0; j < 4; ++j) {
            const f32x4 sh = *(const f32x4*)(md + 256 * j + 4 * X.lane), sc = *(const f32x4*)(md + 1024 + 256 * j + 4 * X.lane);
            h[j] = v[j] * (sc + 1.f) + sh;
            u32x2 o; o.x = pk2(h[j][0], h[j][1]); o.y = pk2(h[j][2], h[j][3]);
            *(u32x2*)(Hd + (size_t)row * DM + 256 * j + 4 * X.lane) = o;
        }
        if (do_gates) {
            float gs[16];
#pragma unroll
            for (int t = 0; t < 16; ++t) {
                float s = 0.f;
#pragma unroll
                for (int j = 0; j < 4; ++j) { const f32x4 w = *(const LAS f32x4*)(wg + t * 1024 + 256 * j + 4 * X.lane); s += (h[j][0] * w[0] + h[j][1] * w[1]) + (h[j][2] * w[2] + h[j][3] * w[3]); }
                gs[t] = wave_sum(s, X.lane);
            }
            float mine = 0.f;
#pragma unroll
            for (int t = 0; t < 16; ++t) mine = (X.lane == t) ? gs[t] : mine;
            if (X.lane < 16) GT[(size_t)row * 16 + X.lane] = mine + ((const float*)(ws + WS_BG))[lg * 16 + X.lane];
        }
    }
}

struct AttnU {
    int nc0; const bf16_t* k0; const bf16_t* v0;
    int nc1; const bf16_t* k1; const bf16_t* v1; int tok1;
    int kind;
    int krow0; const float* rpb2;
    bool has_sink; float sink2;
};
constexpr float ATT_THR = 6.f;
constexpr int ATT_BUF = 16384, ATT_VOFF = 8192;
DI int att_koff(int row, int p) { return row * 128 + ((p ^ ((row >> 1) & 7)) << 4); }
DI int att_voff(int d, int q) { return d * 128 + ((q ^ ((d >> 1) & 15)) << 3); }
DI void attn_unit(const Ctx& X, const AttnU& D, int t0, int kcol0, int wlo, int whi, const bf16_t* qrow, int qtok, int rq, int qc, bf16_t* outp) {
    const int lane = X.lane, r32 = lane & 31, h2 = lane >> 5, tid = X.tid;
    LAS unsigned char* lbase = X.lds;
    bf16x8 qf[4];
#pragma unroll
    for (int ks = 0; ks < 4; ++ks) qf[ks] = *(const bf16x8*)(qrow + 16 * ks + 8 * h2);
    f32x16 o[2];
#pragma unroll
    for (int r = 0; r < 16; ++r) { o[0][r] = 0.f; o[1][r] = 0.f; }
    float m = -1e30f, lsum = 0.f;
    const int nc = D.nc0 + D.nc1;
    const int wstart = min(max(rq - 4, 0), 8);
    unsigned colbits = 0u; int cbase = 0;
    if (D.kind == 2) {
        const int cs = min(max(qc - 8, 0), 48);
#pragma unroll
        for (int r = 0; r < 16; ++r) { const int kcol = kcol0 + 4 * h2 + (r & 3) + 8 * (r >> 2); if (kcol >= cs && kcol < cs + 16) colbits |= 1u << r; }
        cbase = kcol0 + 4 * h2 - qc + 15;
    }
    const int srow = tid >> 3, sp = tid & 7;
    const int kdst = att_koff(srow, sp);
    const int vx = (srow >> 1) & 15, vdst = ATT_VOFF + srow * 128 + ((((2 * sp) ^ vx) & ~1) << 3); const bool vswap = vx & 1;
    u32x4 kreg, vreg;
#define ATT_GLOAD(c) do { \
        const bf16_t* kp_; const bf16_t* vp_; \
        if ((c) < D.nc0) { kp_ = D.k0 + (size_t)(64 * (c) + srow) * 64 + 8 * sp; vp_ = D.v0 + (size_t)srow * 512 + 64 * (c) + 8 * sp; } \
        else { const int tc_ = D.tok1 + 64 * ((c) - D.nc0); kp_ = D.k1 + (size_t)(tc_ + srow) * NZ + 8 * sp; vp_ = D.v1 + (size_t)srow * MTOK + tc_ + 8 * sp; } \
        kreg = *(const u32x4*)kp_; vreg = *(const u32x4*)vp_; \
    } while (0)
#define ATT_LWRITE(bufoff) do { \
        *(LAS u32x4*)(lbase + (bufoff) + kdst) = kreg; \
        u32x4 vv_; vv_.x = vswap ? vreg.z : vreg.x; vv_.y = vswap ? vreg.w : vreg.y; vv_.z = vswap ? vreg.x : vreg.z; vv_.w = vswap ? vreg.y : vreg.w; \
        *(LAS u32x4*)(lbase + (bufoff) + vdst) = vv_; \
    } while (0)
    __syncthreads();
    ATT_GLOAD(0); ATT_LWRITE(0);
    __syncthreads();
    for (int c = 0; c < nc; ++c) {
        const int bufoff = (c & 1) * ATT_BUF;
        if (c + 1 < nc) ATT_GLOAD(c + 1);
        int ntile = 2, T0 = 0, mode = 0, aux = 0;
        if (c >= D.nc0) {
            const int cc = c - D.nc0;
            if (D.kind == 1) { aux = D.tok1 + 64 * cc; mode = 1; }
            else if (D.kind == 2) { aux = D.krow0 + cc; mode = 2; T0 = kcol0; ntile = (aux >= wlo && aux < whi) ? 1 : 0; }
        }
#pragma unroll 1
        for (int j = 0; j < ntile; ++j, T0 += 32) {
            int tk = 0;
            if (mode == 1) { tk = aux + T0; if (tk < t0 - 128 || tk > t0 + 128) continue; }
            f32x16 s;
#pragma unroll
            for (int r = 0; r < 16; ++r) s[r] = 0.f;
            {
                const int krow = T0 + r32; const int kx = (krow >> 1) & 7;
                LAS unsigned char* kb = lbase + bufoff + krow * 128;
#pragma unroll
                for (int ks = 0; ks < 4; ++ks) { const bf16x8 kf = *(const LAS bf16x8*)(kb + (((2 * ks + h2) ^ kx) << 4)); s = MFMA32(kf, qf[ks], s); }
            }
            if (mode == 1) {
                if (tk == t0 + 128 || tk == t0 - 128) {
                    const int kp0 = tk + 4 * h2;
#pragma unroll
                    for (int r = 0; r < 16; ++r) { const int kpos = kp0 + (r & 3) + 8 * (r >> 2); const int dd = qtok - kpos; if (dd > 128 || dd < -128) s[r] = -1e30f; }
                }
            } else if (mode == 2) {
                const int krow = aux;
                const bool rowok = (krow >= wstart) && (krow < wstart + 8);
                const float* bp = D.rpb2 + min(max(krow - rq + 7, 0), 14) * 31 + cbase;
#pragma unroll
                for (int g = 0; g < 4; ++g) {
                    const f32x4u bb = *(const f32x4u*)(bp + 8 * g);
#pragma unroll
                    for (int e = 0; e < 4; ++e) { const int r = 4 * g + e; const bool ok = rowok && ((colbits >> r) & 1u); s[r] = ok ? s[r] + bb[e] : -1e30f; }
                }
            }
            float tm = fmaxf(fmaxf(s[0], s[1]), fmaxf(s[2], s[3]));
#pragma unroll
            for (int r = 4; r < 16; r += 4) tm = fmaxf(tm, fmaxf(fmaxf(s[r], s[r + 1]), fmaxf(s[r + 2], s[r + 3])));
            tm = swap_max(tm);
            if (__any(tm > m + ATT_THR)) {
                const float mn = fmaxf(m, tm), alpha = __builtin_amdgcn_exp2f(m - mn);
                m = mn; lsum *= alpha;
#pragma unroll
                for (int r = 0; r < 16; ++r) { o[0][r] *= alpha; o[1][r] *= alpha; }
            }
            float ps = 0.f;
#pragma unroll
            for (int r = 0; r < 16; ++r) { s[r] = __builtin_amdgcn_exp2f(s[r] - m); ps += s[r]; }
            lsum += ps;
            u32x4 p0, p1;
            p0.x = pk2(s[0], s[1]); p0.y = pk2(s[2], s[3]); p0.z = pk2(s[4], s[5]); p0.w = pk2(s[6], s[7]);
            p1.x = pk2(s[8], s[9]); p1.y = pk2(s[10], s[11]); p1.z = pk2(s[12], s[13]); p1.w = pk2(s[14], s[15]);
            const bf16x8 pb0 = __builtin_bit_cast(bf16x8, p0), pb1 = __builtin_bit_cast(bf16x8, p1);
            const int q0 = (T0 >> 2) + h2;
#pragma unroll
            for (int dt = 0; dt < 2; ++dt) {
                const int d = 32 * dt + r32; const int vxr = (d >> 1) & 15;
                LAS unsigned char* vb = lbase + bufoff + ATT_VOFF + d * 128;
                const s16x4 a0 = *(const LAS s16x4*)(vb + (((q0) ^ vxr) << 3)), a1 = *(const LAS s16x4*)(vb + (((q0 + 2) ^ vxr) << 3));
                const s16x4 b0 = *(const LAS s16x4*)(vb + (((q0 + 4) ^ vxr) << 3)), b1 = *(const LAS s16x4*)(vb + (((q0 + 6) ^ vxr) << 3));
                o[dt] = MFMA32(__builtin_shufflevector(a0, a1, 0, 1, 2, 3, 4, 5, 6, 7), pb0, o[dt]);
                o[dt] = MFMA32(__builtin_shufflevector(b0, b1, 0, 1, 2, 3, 4, 5, 6, 7), pb1, o[dt]);
            }
        }
        if (c + 1 < nc) ATT_LWRITE(ATT_BUF - bufoff);
        __syncthreads();
    }
#undef ATT_GLOAD
#undef ATT_LWRITE
    float lt = swap_sum(lsum);
    if (D.has_sink) lt += __builtin_amdgcn_exp2f(D.sink2 - m);
    const float inv = 1.f / lt;
#pragma unroll
    for (int dt = 0; dt < 2; ++dt)
#pragma unroll
        for (int g = 0; g < 4; ++g) {
            u32x2 w; w.x = pk2(o[dt][4 * g] * inv, o[dt][4 * g + 1] * inv); w.y = pk2(o[dt][4 * g + 2] * inv, o[dt][4 * g + 3] * inv);
            *(u32x2*)(outp + 32 * dt + 8 * g + 4 * h2) = w;
        }
}

DI void chunk_gates(const float* gates, int dir, int h, float fb, int lane, LAS float* sb, LAS float* sa, LAS float* sA, float& Bc, float& Amax) {
    const float* g = gates + (size_t)lane * 16;
    const float li = g[8 * dir + h], gf = g[8 * dir + 4 + h] + fb;
    const float lf = fminf(gf, 0.f) - __builtin_amdgcn_logf(1.f + fexp(-fabsf(gf))) * 0.6931471805599453f;
    float b = lf;
    if (dir == 0) {
#pragma unroll
        for (int off = 1; off < 64; off <<= 1) { const float t = shfl_f(b, lane - off); if (lane >= off) b += t; }
    } else {
#pragma unroll
        for (int off = 1; off < 64; off <<= 1) { const float t = shfl_f(b, lane + off); if (lane + off < 64) b += t; }
    }
    const float a = li - b; float Ar = a;
    if (dir == 0) {
#pragma unroll
        for (int off = 1; off < 64; off <<= 1) { const float t = shfl_f(Ar, lane - off); if (lane >= off) Ar = fmaxf(Ar, t); }
    } else {
#pragma unroll
        for (int off = 1; off < 64; off <<= 1) { const float t = shfl_f(Ar, lane + off); if (lane + off < 64) Ar = fmaxf(Ar, t); }
    }
    sb[lane] = b; sa[lane] = a; sA[lane] = Ar;
    const int el = dir == 0 ? 63 : 0;
    Bc = shfl_f(b, el); Amax = shfl_f(Ar, el);
    LDS_WAIT(); asm volatile("" ::: "memory");
}

DI void mlstm_p1(const Ctx& X, int l, int is_lat, int b, int h, int dir, int tb) {
    const Args& A = *X.a; unsigned char* ws = X.ws;
    const int T = is_lat ? LAT_T : CTX_T, nch = T / 64;
    const int rowbase = is_lat ? MCTX + b * LAT_T : b * CTX_T;
    const int cdbase = is_lat ? ((b * 4 + h) * 2) * 16 : 1024 + ((b * 4 + h) * 2) * 4;
    const bf16_t* Z = (const bf16_t*)(ws + WS_OV + OV_Z) + (size_t)rowbase * NZ;
    const bf16_t* VT = (const bf16_t*)(ws + WS_OV + OV_VT) + (size_t)(VR_MV + 64 * h) * MTOK + rowbase;
    const float* GT = (const float*)(ws + WS_GATES) + (size_t)rowbase * 16;
    float* U = (float*)(ws + WS_OV + OV_U); bf16_t* CST = (bf16_t*)(ws + WS_OV + OV_CST);
    float* NN = (float*)(ws + WS_OV + OV_NN); float* NST = (float*)(ws + WS_OV + OV_NST); float* SC = (float*)(ws + WS_OV + OV_SC);
    (void)Z; (void)VT; (void)GT; (void)U; (void)CST; (void)NN; (void)NST; (void)SC; (void)nch; (void)cdbase; (void)A;
    const int lane = X.lane, r32 = lane & 31, h2 = lane >> 5;
    LAS float* sb = (LAS float*)(X.lds + X.wave * 2048); LAS float* sa = sb + 64; LAS float* sA = sb + 128; LAS float* sw = sb + 192;
    {
        bf16x8 ident[2];
#pragma unroll
        for (int e = 0; e < 2; ++e)
#pragma unroll
            for (int j = 0; j < 8; ++j) ident[e][j] = (r32 == 16 * e + 8 * h2 + j) ? (short)0x3F80 : (short)0;
        {
            const int cd = cdbase + dir * nch + tb, tok0 = tb * 64;
            const float fb = A.in[I_FB][(l * 2 + dir) * 4 + h];
            float Bc, Amax;
            chunk_gates(GT + (size_t)tok0 * 16, dir, h, fb, lane, sb, sa, sA, Bc, Amax);
            sw[lane] = fexp(sa[lane] - Amax);
            LDS_WAIT(); asm volatile("" ::: "memory");
            f32x16 acc[2][2];
#pragma unroll
            for (int i = 0; i < 2; ++i)
#pragma unroll
                for (int j = 0; j < 2; ++j)
#pragma unroll
                    for (int r = 0; r < 16; ++r) acc[i][j][r] = 0.f;
            float nacc[2] = {0.f, 0.f};
#pragma unroll
            for (int st = 0; st < 2; ++st) {
                bf16x8 kf[4];
                const bf16_t* kp = Z + (size_t)(tok0 + 32 * st + r32) * NZ + ZC_MK + 64 * h + 8 * h2;
#pragma unroll
                for (int ks = 0; ks < 4; ++ks) kf[ks] = *(const bf16x8*)(kp + 16 * ks);
                bf16x8 va[2][2];
                const bf16_t* vp = VT + (size_t)r32 * MTOK + tok0 + 32 * st + 4 * h2;
#pragma unroll
                for (int vt = 0; vt < 2; ++vt)
#pragma unroll
                    for (int s2 = 0; s2 < 2; ++s2) { const s16x4 a0 = *(const s16x4*)(vp + (size_t)(32 * vt) * MTOK + 16 * s2), a1 = *(const s16x4*)(vp + (size_t)(32 * vt) * MTOK + 16 * s2 + 8);
                        va[vt][s2] = __builtin_shufflevector(a0, a1, 0, 1, 2, 3, 4, 5, 6, 7); }
                float wr_[16];
#pragma unroll
                for (int r = 0; r < 16; ++r) wr_[r] = sw[32 * st + crow(r, h2)];
#pragma unroll
                for (int dt = 0; dt < 2; ++dt) {
                    f32x16 x;
#pragma unroll
                    for (int r = 0; r < 16; ++r) x[r] = 0.f;
                    x = MFMA32(kf[2 * dt], ident[0], x);
                    x = MFMA32(kf[2 * dt + 1], ident[1], x);
#pragma unroll
                    for (int r = 0; r < 16; ++r) { x[r] *= wr_[r]; nacc[dt] += x[r]; }
                    u32x4 p0, p1;
                    p0.x = pk2(x[0], x[1]); p0.y = pk2(x[2], x[3]); p0.z = pk2(x[4], x[5]); p0.w = pk2(x[6], x[7]);
                    p1.x = pk2(x[8], x[9]); p1.y = pk2(x[10], x[11]); p1.z = pk2(x[12], x[13]); p1.w = pk2(x[14], x[15]);
                    const bf16x8 xb0 = __builtin_bit_cast(bf16x8, p0), xb1 = __builtin_bit_cast(bf16x8, p1);
#pragma unroll
                    for (int vt = 0; vt < 2; ++vt) { acc[vt][dt] = MFMA32(va[vt][0], xb0, acc[vt][dt]); acc[vt][dt] = MFMA32(va[vt][1], xb1, acc[vt][dt]); }
                }
            }
            float* Ug = U + (size_t)cd * 4096;
#pragma unroll
            for (int vt = 0; vt < 2; ++vt)
#pragma unroll
                for (int dt = 0; dt < 2; ++dt)
#pragma unroll
                    for (int r = 0; r < 16; ++r) Ug[(32 * vt + crow(r, h2)) * 64 + 32 * dt + r32] = acc[vt][dt][r];
#pragma unroll
            for (int dt = 0; dt < 2; ++dt) { const float t = swap_sum(nacc[dt]); if (h2 == 0) NN[(size_t)cd * 64 + 32 * dt + r32] = t; }
            if (lane == 0) { SC[cd * 4 + 0] = Bc; SC[cd * 4 + 1] = Amax; }
        }
    }
}

DI void mlstm_p2(const Ctx& X, int l, int is_lat, int b, int h, int dir) {
    const Args& A = *X.a; unsigned char* ws = X.ws;
    const int T = is_lat ? LAT_T : CTX_T, nch = T / 64;
    const int rowbase = is_lat ? MCTX + b * LAT_T : b * CTX_T;
    const int cdbase = is_lat ? ((b * 4 + h) * 2) * 16 : 1024 + ((b * 4 + h) * 2) * 4;
    const bf16_t* Z = (const bf16_t*)(ws + WS_OV + OV_Z) + (size_t)rowbase * NZ;
    const bf16_t* VT = (const bf16_t*)(ws + WS_OV + OV_VT) + (size_t)(VR_MV + 64 * h) * MTOK + rowbase;
    const float* GT = (const float*)(ws + WS_GATES) + (size_t)rowbase * 16;
    float* U = (float*)(ws + WS_OV + OV_U); bf16_t* CST = (bf16_t*)(ws + WS_OV + OV_CST);
    float* NN = (float*)(ws + WS_OV + OV_NN); float* NST = (float*)(ws + WS_OV + OV_NST); float* SC = (float*)(ws + WS_OV + OV_SC);
    (void)Z; (void)VT; (void)GT; (void)U; (void)CST; (void)NN; (void)NST; (void)SC; (void)nch; (void)cdbase; (void)A;
    const int tid = X.tid;
    float C[8], nv = 0.f, m = 0.f;
    if (is_lat) {
        const float* c0 = A.in[I_SC] + ((((size_t)b * DEPTH + l) * 2 + dir) * 4 + h) * 4096;
#pragma unroll
        for (int i = 0; i < 8; ++i) C[i] = c0[tid + 512 * i];
        if (tid < 64) nv = A.in[I_SN][((((size_t)b * DEPTH + l) * 2 + dir) * 4 + h) * 64 + tid];
        m = A.in[I_SM][(((size_t)b * DEPTH + l) * 2 + dir) * 4 + h];
    } else {
#pragma unroll
        for (int i = 0; i < 8; ++i) C[i] = 0.f;
    }
    float Ur[16][8], nnr[16], bcr[16], amr[16];
#pragma unroll
    for (int step = 0; step < 16; ++step) {
        if (step < nch) {
            const int cd = cdbase + dir * nch + (dir ? nch - 1 - step : step);
#pragma unroll
            for (int i = 0; i < 8; ++i) Ur[step][i] = U[(size_t)cd * 4096 + tid + 512 * i];
            nnr[step] = (tid < 64) ? NN[(size_t)cd * 64 + tid] : 0.f;
            bcr[step] = SC[cd * 4 + 0]; amr[step] = SC[cd * 4 + 1];
        }
    }
#pragma unroll
    for (int step = 0; step < 16; ++step) {
        if (step < nch) {
            const int cd = cdbase + dir * nch + (dir ? nch - 1 - step : step);
            bf16_t* cs = CST + (size_t)cd * 4096;
#pragma unroll
            for (int i = 0; i < 8; ++i) cs[tid + 512 * i] = (bf16_t)(pk2(C[i], 0.f) & 0xffffu);
            if (tid < 64) NST[(size_t)cd * 64 + tid] = nv;
            if (tid == 0) SC[cd * 4 + 2] = m;
            const float M63 = fmaxf(m, amr[step]), f1 = fexp(m - M63), f2 = fexp(amr[step] - M63);
#pragma unroll
            for (int i = 0; i < 8; ++i) C[i] = f1 * C[i] + f2 * Ur[step][i];
            nv = f1 * nv + f2 * nnr[step];
            m = bcr[step] + M63;
        }
    }
    if (!is_lat) {
        float* oc = A.out + O_MC + ((((size_t)b * DEPTH + l) * 2 + dir) * 4 + h) * 4096;
#pragma unroll
        for (int i = 0; i < 8; ++i) oc[tid + 512 * i] = C[i];
        if (tid < 64) A.out[O_MN + ((((size_t)b * DEPTH + l) * 2 + dir) * 4 + h) * 64 + tid] = nv;
        if (tid == 0) A.out[O_MM + (((size_t)b * DEPTH + l) * 2 + dir) * 4 + h] = m;
    }
}

DI void mlstm_p3(const Ctx& X, int l, int is_lat, int b, int h, int tb, int th) {
    const Args& A = *X.a; unsigned char* ws = X.ws;
    const int T = is_lat ? LAT_T : CTX_T, nch = T / 64;
    const int rowbase = is_lat ? MCTX + b * LAT_T : b * CTX_T;
    const int cdbase = is_lat ? ((b * 4 + h) * 2) * 16 : 1024 + ((b * 4 + h) * 2) * 4;
    const bf16_t* Z = (const bf16_t*)(ws + WS_OV + OV_Z) + (size_t)rowbase * NZ;
    const bf16_t* VT = (const bf16_t*)(ws + WS_OV + OV_VT) + (size_t)(VR_MV + 64 * h) * MTOK + rowbase;
    const float* GT = (const float*)(ws + WS_GATES) + (size_t)rowbase * 16;
    float* U = (float*)(ws + WS_OV + OV_U); bf16_t* CST = (bf16_t*)(ws + WS_OV + OV_CST);
    float* NN = (float*)(ws + WS_OV + OV_NN); float* NST = (float*)(ws + WS_OV + OV_NST); float* SC = (float*)(ws + WS_OV + OV_SC);
    (void)Z; (void)VT; (void)GT; (void)U; (void)CST; (void)NN; (void)NST; (void)SC; (void)nch; (void)cdbase; (void)A;
    const int lane = X.lane, r32 = lane & 31, h2 = lane >> 5;
    LAS float* sb = (LAS float*)(X.lds + X.wave * 2048); LAS float* sa = sb + 64; LAS float* sA = sb + 128;
    bf16_t* MIX = (bf16_t*)(ws + WS_OV + OV_MIX) + (size_t)rowbase * DM;
    {
        const int tok0 = tb * 64, t = 32 * th + r32;
        bf16x8 qf[4];
#pragma unroll
        for (int ks = 0; ks < 4; ++ks) qf[ks] = *(const bf16x8*)(Z + (size_t)(tok0 + t) * NZ + ZC_MQ + 64 * h + 16 * ks + 8 * h2);
        f32x16 hs[2];
#pragma unroll
        for (int r = 0; r < 16; ++r) { hs[0][r] = 0.f; hs[1][r] = 0.f; }
#pragma unroll 1
        for (int dir = 0; dir < 2; ++dir) {
            const int cd = cdbase + dir * nch + tb;
            const float fb = A.in[I_FB][(l * 2 + dir) * 4 + h];
            const float mc = SC[cd * 4 + 2];
            float Bc, Amax;
            chunk_gates(GT + (size_t)tok0 * 16, dir, h, fb, lane, sb, sa, sA, Bc, Amax);
            const float Mt = fmaxf(mc, sA[t]), wprev = fexp(mc - Mt), mt = sb[t] + Mt;
            f32x16 num[2];
#pragma unroll
            for (int r = 0; r < 16; ++r) { num[0][r] = 0.f; num[1][r] = 0.f; }
            {
                const bf16_t* cs = CST + (size_t)cd * 4096 + r32 * 64 + 8 * h2;
#pragma unroll
                for (int ks = 0; ks < 4; ++ks)
#pragma unroll
                    for (int vt = 0; vt < 2; ++vt) { const bf16x8 cf = *(const bf16x8*)(cs + (32 * vt) * 64 + 16 * ks); num[vt] = MFMA32(cf, qf[ks], num[vt]); }
            }
#pragma unroll
            for (int r = 0; r < 16; ++r) { num[0][r] *= wprev; num[1][r] *= wprev; }
            float nq = 0.f;
            {
                const float* nsp = NST + (size_t)cd * 64 + 8 * h2;
#pragma unroll
                for (int ks = 0; ks < 4; ++ks) {
                    const f32x4 n0 = *(const f32x4*)(nsp + 16 * ks), n1 = *(const f32x4*)(nsp + 16 * ks + 4);
#pragma unroll
                    for (int j = 0; j < 4; ++j) nq += n0[j] * bfs2f(qf[ks][j]) + n1[j] * bfs2f(qf[ks][4 + j]);
                }
            }
            float den = 0.f;
#pragma unroll
            for (int st = 0; st < 2; ++st) {
                f32x16 s;
#pragma unroll
                for (int r = 0; r < 16; ++r) s[r] = 0.f;
#pragma unroll
                for (int ks = 0; ks < 4; ++ks) { const bf16x8 kf = *(const bf16x8*)(Z + (size_t)(tok0 + 32 * st + r32) * NZ + ZC_MK + 64 * h + 8 * h2 + 16 * ks); s = MFMA32(kf, qf[ks], s); }
#pragma unroll
                for (int r = 0; r < 16; ++r) {
                    const int sidx = 32 * st + crow(r, h2);
                    const bool ok = dir == 0 ? (sidx <= t) : (sidx >= t);
                    const float w = ok ? fexp(sa[sidx] - Mt) : 0.f;
                    s[r] *= w; den += s[r];
                }
                u32x4 p0, p1;
                p0.x = pk2(s[0], s[1]); p0.y = pk2(s[2], s[3]); p0.z = pk2(s[4], s[5]); p0.w = pk2(s[6], s[7]);
                p1.x = pk2(s[8], s[9]); p1.y = pk2(s[10], s[11]); p1.z = pk2(s[12], s[13]); p1.w = pk2(s[14], s[15]);
                const bf16x8 pb0 = __builtin_bit_cast(bf16x8, p0), pb1 = __builtin_bit_cast(bf16x8, p1);
#pragma unroll
                for (int vt = 0; vt < 2; ++vt) {
                    const bf16_t* vp = VT + (size_t)(32 * vt + r32) * MTOK + tok0 + 32 * st + 4 * h2;
                    const s16x4 a0 = *(const s16x4*)(vp), a1 = *(const s16x4*)(vp + 8), b0 = *(const s16x4*)(vp + 16), b1 = *(const s16x4*)(vp + 24);
                    num[vt] = MFMA32(__builtin_shufflevector(a0, a1, 0, 1, 2, 3, 4, 5, 6, 7), pb0, num[vt]);
                    num[vt] = MFMA32(__builtin_shufflevector(b0, b1, 0, 1, 2, 3, 4, 5, 6, 7), pb1, num[vt]);
                }
            }
            nq = swap_sum(nq);
            den = swap_sum(den) + wprev * nq;
            const float dn = 1.f / fmaxf(fabsf(den), fexp(-mt));
#pragma unroll
            for (int vt = 0; vt < 2; ++vt)
#pragma unroll
                for (int r = 0; r < 16; ++r) hs[vt][r] += num[vt][r] * dn;
        }
        float s1 = 0.f;
#pragma unroll
        for (int r = 0; r < 16; ++r) s1 += hs[0][r] + hs[1][r];
        const float mu = swap_sum(s1) * (1.f / 64.f);
        float s2 = 0.f;
#pragma unroll
        for (int r = 0; r < 16; ++r) { hs[0][r] -= mu; hs[1][r] -= mu; s2 += hs[0][r] * hs[0][r] + hs[1][r] * hs[1][r]; }
        const float rstd = 1.f / sqrtf(swap_sum(s2) * (1.f / 64.f) + LN_EPS);
        const bf16_t* mo = Z + (size_t)(tok0 + t) * NZ + ZC_MO + 64 * h;
        const float* ng = A.in[I_NG] + l * 256 + 64 * h;
        bf16_t* op = MIX + (size_t)(tok0 + t) * DM + 64 * h;
#pragma unroll
        for (int vt = 0; vt < 2; ++vt)
#pragma unroll
            for (int g = 0; g < 4; ++g) {
                const int d0 = 32 * vt + 8 * g + 4 * h2;
                const s16x4 mv = *(const s16x4*)(mo + d0);
                const f32x4 gv = *(const f32x4*)(ng + d0);
                float y[4];
#pragma unroll
                for (int e = 0; e < 4; ++e) { const float og = 1.f / (1.f + fexp(-bfs2f(mv[e]))); y[e] = hs[vt][4 * g + e] * rstd * gv[e] * og; }
                u32x2 w; w.x = pk2(y[0], y[1]); w.y = pk2(y[2], y[3]);
                *(u32x2*)(op + d0) = w;
            }
    }
}

constexpr int PM_LAT = 1 + ((PROBE_DUP >> 10) & 1), PM_CATT = 1 + ((PROBE_DUP >> 11) & 1), PM_P1 = 1 + ((PROBE_DUP >> 12) & 1), PM_P3 = 1 + ((PROBE_DUP >> 13) & 1), PM_P2 = 1 + ((PROBE_DUP >> 14) & 1);
constexpr int NU_P1 = 192 * PM_P1, NU_SLAT = 192 * PM_LAT, NU_NLAT = 192 * PM_LAT, NU_CATT = 192 * PM_CATT, NU_COPY = 16, NU_P2 = 192 * PM_P2, NU_P3 = 192 * PM_P3;
constexpr int NU_A = NU_NLAT + NU_CATT + NU_P1 + NU_COPY, NU_C = NU_P3 + NU_SLAT;
DI void mix_phase(const Ctx& X0, int l, const XcdBarrier& bar) {
    const Args& A = *X0.a; unsigned char* ws = X0.ws;
    const bf16_t* Z = (const bf16_t*)(ws + WS_OV + OV_Z);
    const bf16_t* VT = (const bf16_t*)(ws + WS_OV + OV_VT);
    bf16_t* MIX = (bf16_t*)(ws + WS_OV + OV_MIX);
    volatile LAS unsigned* qslot = (volatile LAS unsigned*)(X0.lds + MISC_OFF) + 12;
    int sub = 0;
    for (;;) {
        Ctx X = X0;
        { int t_ = X0.tid; asm volatile("" : "+v"(t_)); X.tid = t_; X.lane = t_ & 63; X.wave = __builtin_amdgcn_readfirstlane(t_ >> 6); }
        gu32* qhead = (gu32*)ws + CW_Q + 64 * (3 * X0.phase + sub);
        __syncthreads();
        if (X.tid == 0) qslot[0] = __hip_atomic_fetch_add(qhead, 1u, __ATOMIC_RELAXED, __HIP_MEMORY_SCOPE_AGENT);
        __syncthreads();
        const int u = (int)qslot[0];
        if (u >= (sub == 0 ? NU_A : (sub == 1 ? NU_P2 : NU_C))) {
            if (sub == 2) break;
            xcd_barrier(bar); __syncthreads();
            ++sub; continue;
        }
        const int lane = X.lane, r32 = lane & 31;
        int r = u;
        int cls;
        if (sub == 0) { if (r < NU_NLAT) cls = 4; else if ((r -= NU_NLAT) < NU_CATT) cls = 5; else if ((r -= NU_CATT) < NU_P1) cls = 0; else { r -= NU_P1; cls = 6; } }
        else if (sub == 1) cls = 1;
        else { if (r < NU_P3) cls = 2; else { r -= NU_P3; cls = 3; } }
        if (cls != 6) r %= 192;
        if (cls == 1) {
            const int is_lat = r < 64 ? 1 : 0; if (!is_lat) r -= 64;
            mlstm_p2(X, l, is_lat, r >> 3, (r >> 1) & 3, r & 1);
            continue;
        }
        if (cls == 2) {
            const int is_lat = r < 128 ? 1 : 0; if (!is_lat) r -= 128;
            const int idx = r * 8 + X.wave;
            const int bh = is_lat ? idx >> 5 : idx >> 3, tb = is_lat ? (idx >> 1) & 15 : (idx >> 1) & 3;
            mlstm_p3(X, l, is_lat, bh >> 2, bh & 3, tb, idx & 1);
            continue;
        }
        if (cls == 0) {
            const int is_lat = r < 128 ? 1 : 0; if (!is_lat) r -= 128;
            const int idx = r * 8 + X.wave;
            mlstm_p1(X, l, is_lat, is_lat ? idx >> 7 : idx >> 5, is_lat ? (idx >> 5) & 3 : (idx >> 3) & 3, is_lat ? (idx >> 4) & 1 : (idx >> 2) & 1, is_lat ? idx & 15 : idx & 3);
            continue;
        }
        if (cls != 6) {
            AttnU D; const bf16_t* qp; bf16_t* op; int qt, rq = 0, qc = 0, t0 = 0, kcol0 = 0, wlo = 0, whi = 0;
            if (cls == 3) {
                const int b = r / 24, qh = (r % 24) / 4, qb = r % 4, kv = qh / 3;
                const int rowbase = MCTX + b * LAT_T; t0 = qb * 256 + X.wave * 32;
                D.nc0 = 8; D.k0 = (const bf16_t*)(ws + WS_CKS) + (size_t)((b * DEPTH + l) * 2 + kv) * 512 * 64; D.v0 = (const bf16_t*)(ws + WS_CVS) + (size_t)((b * DEPTH + l) * 2 + kv) * 64 * 512;
                const int tlo = max(qb * 256 - 128, 0), thi = min(qb * 256 + 384, LAT_T);
                D.nc1 = (thi - tlo) / 64; D.k1 = Z + (size_t)rowbase * NZ + ZC_SK + 64 * kv; D.v1 = VT + (size_t)(VR_SV + 64 * kv) * MTOK + rowbase;
                D.tok1 = tlo; D.kind = 1; D.krow0 = 0; D.rpb2 = (const float*)(ws + WS_RPB2);
                D.has_sink = true; D.sink2 = A.in[I_SINK][l * 6 + qh] * LOG2E;
                qt = t0 + r32;
                qp = Z + (size_t)(rowbase + qt) * NZ + ZC_SQ + 64 * qh; op = MIX + (size_t)(rowbase + qt) * DM + 256 + 64 * qh;
            } else if (cls == 4) {
                const int b = r / 24, h = (r % 24) / 4, rg = r % 4;
                const int rowbase = MCTX + b * LAT_T;
                const int r0 = rg * 4 + (X.wave >> 2) * 2, cb = X.wave & 3;
                rq = r0 + (r32 >> 4); qc = 16 * cb + (r32 & 15); qt = rq * 64 + qc;
                D.nc0 = 8; D.k0 = (const bf16_t*)(ws + WS_CKN) + (size_t)((b * DEPTH + l) * 6 + h) * 512 * 64; D.v0 = (const bf16_t*)(ws + WS_CVN) + (size_t)((b * DEPTH + l) * 6 + h) * 64 * 512;
                wlo = min(max(r0 - 4, 0), 8); whi = min(max(r0 + 1 - 4, 0), 8) + 8; kcol0 = min(max(16 * cb - 8, 0), 32);
                const int ulo = min(max(rg * 4 - 4, 0), 8), uhi = min(max(rg * 4 + 3 - 4, 0), 8) + 8;
                D.krow0 = ulo; D.nc1 = uhi - ulo;
                D.k1 = Z + (size_t)rowbase * NZ + ZC_NK + 64 * h; D.v1 = VT + (size_t)(VR_NV + 64 * h) * MTOK + rowbase;
                D.tok1 = ulo * 64; D.kind = 2; D.rpb2 = (const float*)(ws + WS_RPB2) + (size_t)(l * 6 + h) * RPB_STRIDE + RPB_OFF;
                D.has_sink = false; D.sink2 = 0.f;
                qp = Z + (size_t)(rowbase + qt) * NZ + ZC_NQ + 64 * h; op = MIX + (size_t)(rowbase + qt) * DM + 640 + 64 * h;
            } else {
                const bool is_swa = r < 96; if (!is_swa) r -= 96;
                const int b = r / 6, hh = r % 6, kv = hh / 3;
                const int rowbase = b * CTX_T; qt = X.wave * 32 + r32;
                D.nc0 = 0; D.k0 = Z; D.v0 = VT; D.nc1 = 4; D.tok1 = 0; D.kind = 0; D.krow0 = 0; D.rpb2 = (const float*)(ws + WS_RPB2);
                if (is_swa) { D.k1 = Z + (size_t)rowbase * NZ + ZC_SK + 64 * kv; D.v1 = VT + (size_t)(VR_SV + 64 * kv) * MTOK + rowbase; D.has_sink = true; D.sink2 = A.in[I_SINK][l * 6 + hh] * LOG2E; }
                else { D.k1 = Z + (size_t)rowbase * NZ + ZC_NK + 64 * hh; D.v1 = VT + (size_t)(VR_NV + 64 * hh) * MTOK + rowbase; D.has_sink = false; D.sink2 = 0.f; }
                qp = Z + (size_t)(rowbase + qt) * NZ + (is_swa ? ZC_SQ : ZC_NQ) + 64 * hh; op = MIX + (size_t)(rowbase + qt) * DM + (is_swa ? 256 : 640) + 64 * hh;
            }
            attn_unit(X, D, t0, kcol0, wlo, whi, qp, qt, rq, qc, op);
            continue;
        }
        {
            const int b = r, rowbase = b * CTX_T;
            for (int e = X.tid; e < 256 * 64; e += 512) {
                const int t = e >> 6, c8 = (e & 63) * 8;
                const int zc = (c8 < 128) ? ZC_SK + c8 : ZC_NK + (c8 - 128);
                const bf16x8 v = *(const bf16x8*)(Z + (size_t)(rowbase + t) * NZ + zc);
                float* dst;
                if (c8 < 128) dst = A.out + O_SWAK + ((((size_t)b * DEPTH + l) * 2 + (c8 >> 6)) * 256 + t) * 64 + (c8 & 63);
                else { const int cc = c8 - 128; dst = A.out + O_NATK + ((((size_t)b * DEPTH + l) * 6 + (cc >> 6)) * 256 + t) * 64 + (cc & 63); }
                f32x4 o0, o1;
#pragma unroll
                for (int k = 0; k < 4; ++k) { o0[k] = bfs2f(v[k]); o1[k] = bfs2f(v[4 + k]); }
                *(f32x4*)dst = o0; *(f32x4*)(dst + 4) = o1;
            }
            for (int task = X.wave; task < 64; task += 8) {
                const int hd = task >> 3, tblk = task & 7;
                const bf16_t* src = VT + (size_t)(VR_SV + 64 * hd + lane) * MTOK + rowbase + tblk * 32;
                float* dst = (hd < 2) ? A.out + O_SWAV + ((((size_t)b * DEPTH + l) * 2 + hd) * 256 + tblk * 32) * 64 + lane
                                      : A.out + O_NATV + ((((size_t)b * DEPTH + l) * 6 + (hd - 2)) * 256 + tblk * 32) * 64 + lane;
#pragma unroll
                for (int q = 0; q < 4; ++q) { const bf16x8 v = *(const bf16x8*)(src + 8 * q);
#pragma unroll
                    for (int k = 0; k < 8; ++k) dst[(size_t)(8 * q + k) * 64] = bfs2f(v[k]); }
            }
        }
    }
}

constexpr int ndup_layer() { int n = 0; for (int s = 0; s < 7; ++s) n += (PROBE_DUP >> s) & 1; return n; }
constexpr int LSTRIDE = 7 + ndup_layer(), NPRE = 2 + ((PROBE_DUP >> 7) & 1);
constexpr int NPHASE = NPRE + LSTRIDE * DEPTH;
DI int stage_of(int k) { if (PROBE_DUP == 0) return k; int sidx = -1, c = 0;
#pragma unroll
    for (int s = 0; s < 7; ++s) { if (k == c) sidx = s; ++c; if ((PROBE_DUP >> s) & 1) { if (k == c) sidx = s; ++c; } }
    return sidx; }
__global__ void __launch_bounds__(512, 2) fwd_kernel(Args args) {
    extern __shared__ __attribute__((aligned(16))) unsigned char lds_raw[];
    Ctx X; X.a = &args; X.lds = (LAS unsigned char*)lds_raw; X.ws = args.ws;
    X.tid = threadIdx.x; X.lane = X.tid & 63; X.wave = __builtin_amdgcn_readfirstlane(X.tid >> 6);
    const int wave0 = X.wave;
    X.G = gridDim.x; { const int bx = blockIdx.x; X.vcu = (X.G % 8 == 0) ? (bx % 8) * (X.G / 8) + bx / 8 : bx; }
    volatile LAS unsigned* MISC = (volatile LAS unsigned*)(X.lds + MISC_OFF);
    for (int u = X.tid; u < (LDS_BYTES - LDSCTL_OFF) / 4; u += 512) ((LAS unsigned*)(X.lds + LDSCTL_OFF))[u] = 0u;
    __syncthreads();
    const bool one_launch = (args.ph_hi - args.ph_lo) > 1;
    XcdBarrier bar; bar.bar = (unsigned*)(args.ws) + CW_BAR; bar.x = 0; bar.st = nullptr;
    if (one_launch) bar = xcd_barrier_post((unsigned*)(args.ws) + CW_BAR, MISC + 8);
    const int lo = args.ph_lo, hi = args.ph_hi;
    unsigned char* ws = args.ws;
    for (int ph = lo; ph < hi; ++ph) {
        { unsigned zz_ = 0u; asm volatile("" : "+v"(zz_)); int t_ = (wave0 << 6) | (int)__builtin_amdgcn_mbcnt_hi(~0u, __builtin_amdgcn_mbcnt_lo(~0u, zz_)); asm volatile("" : "+v"(t_)); X.tid = t_; X.lane = t_ & 63; X.wave = __builtin_amdgcn_readfirstlane(t_ >> 6);
          size_t z_ = 0; asm volatile("" : "+s"(z_)); X.ws = args.ws + z_; ws = X.ws; X.phase = ph; }
        const int l = ph < NPRE ? 0 : (ph - NPRE) / LSTRIDE, sidx = ph < NPRE ? -1 : stage_of((ph - NPRE) % LSTRIDE);
        if (ph < NPRE - 1) p0_prologue(X);
        else if (ph == NPRE - 1 || sidx == 3 || sidx == 6) row_pass(X, ph == NPRE - 1 ? 0 : (sidx == 3 ? 1 : 2), l);
        else if (sidx == 1) mix_phase(X, l, bar);
        else {
            pg8::Gemm g; pg8::Epi E{}; int nN;
            if (sidx == 0) {
                g = pg8::Gemm{(const bf16_t*)(ws + WS_H), (const bf16_t*)(ws + WS_WIN + l * SZ_WIN_L), DM, 48, 11, 8, true}; nN = 11;
                E.kind = pg8::EPI_G1; E.Z = (bf16_t*)(ws + WS_OV + OV_Z); E.VT = (bf16_t*)(ws + WS_OV + OV_VT); E.binz = (const float*)(ws + WS_BINZ) + l * NIN; E.rope = (const float*)(ws + WS_ROPE);
            } else if (sidx == 2) {
                g = pg8::Gemm{(const bf16_t*)(ws + WS_OV + OV_MIX), (const bf16_t*)(ws + WS_WOUT + l * SZ_WOUT_L), DM, 48, 4, 4, false}; nN = 4;
                E.kind = pg8::EPI_RES;
                if (l == 0) { E.xres_ctx = args.in[I_XP]; E.xres_lat = args.in[I_XS]; } else { E.xres_ctx = args.out + O_Y; E.xres_lat = args.out + O_Y + (size_t)MCTX * DM; }
                E.out = (float*)(ws + WS_X1); E.gvec = (const float*)(ws + WS_MODS) + (size_t)l * 9 * 6144 + 2048;
            } else if (sidx == 4) {
                g = pg8::Gemm{(const bf16_t*)(ws + WS_HM), (const bf16_t*)(ws + WS_W1 + l * SZ_W1_L), DM, 48, 16, 16, true}; nN = 16;
                E.kind = pg8::EPI_RELU2; E.H1 = (bf16_t*)(ws + WS_OV + OV_H1);
            } else {
                g = pg8::Gemm{(const bf16_t*)(ws + WS_OV + OV_H1), (const bf16_t*)(ws + WS_W2 + l * SZ_W1_L), DFF, 48, 4, 4, false}; nN = 4;
                E.kind = pg8::EPI_RES;
                E.xres_ctx = (const float*)(ws + WS_X1); E.xres_lat = (const float*)(ws + WS_X1) + (size_t)MCTX * DM;
                E.out = (float*)(ws + WS_X1); E.gvec = (const float*)(ws + WS_MODS) + (size_t)l * 9 * 6144 + 5120;
            }
            pg8::StaticOrder S; S.init(48, nN, X.G, (int)blockIdx.x);
            pg8::gemm_phase(X.lds, g, S, E, X.tid);
        }
        if ((PROBE_DUP >> 8) & 1) { xcd_barrier(bar); __syncthreads(); xcd_barrier(bar); __syncthreads(); }
        if (ph + 1 < hi) xcd_barrier(bar); else { VM_WAIT(); }
        __syncthreads();
    }
}

extern "C" void kernel_launch(void* const* d_in, const int* in_sizes, int n_in, void* d_out, int out_size, void* d_ws, size_t ws_size, hipStream_t stream) {
    static int grid = 0;
    if (grid == 0) {
        if (n_in != 26 || ws_size < WS_END) { fprintf(stderr, "kernel_launch: n_in %d ws %zu (need %zu)\n", n_in, ws_size, (size_t)WS_END); grid = -1; return; }
        int dev = 0, cus = 0;
        if (hipGetDevice(&dev) != hipSuccess || hipDeviceGetAttribute(&cus, hipDeviceAttributeMultiprocessorCount, dev) != hipSuccess) { grid = -1; return; }
        if (hipFuncSetAttribute((const void*)fwd_kernel, hipFuncAttributeMaxDynamicSharedMemorySize, LDS_BYTES) != hipSuccess) { grid = -1; return; }
        (void)hipGetLastError();
        grid = cus;
    }
    if (grid < 0) return;
    if (hipMemsetAsync(d_ws, 0, CTL_BYTES, stream) != hipSuccess) return;
    Args a{};
    for (int i = 0; i < 26; ++i) a.in[i] = (const float*)d_in[i];
    a.out = (float*)d_out; a.ws = (unsigned char*)d_ws;
#if MK_N_LAUNCHES == 1
    a.ph_lo = 0; a.ph_hi = NPHASE; a.li = 0;
    hipLaunchKernelGGL(fwd_kernel, dim3(grid), dim3(512), LDS_BYTES, stream, a);
#else
    for (int p = 0; p < NPHASE; ++p) { a.ph_lo = p; a.ph_hi = p + 1; a.li = p; hipLaunchKernelGGL(fwd_kernel, dim3(grid), dim3(512), LDS_BYTES, stream, a); }
#endif
}
```

```cpp
#include <hip/hip_runtime.h>
#include <cstdio>
#include <cstdint>

#ifndef PROBE_DUP
#define PROBE_DUP 0
#endif
#ifndef MK_N_LAUNCHES
#define MK_N_LAUNCHES 1
#endif

#define DI __device__ __forceinline__
#define LAS __attribute__((address_space(3)))
#define GAS __attribute__((address_space(1)))
typedef unsigned short bf16_t;
typedef short bf16x8 __attribute__((ext_vector_type(8)));
typedef short s16x4 __attribute__((ext_vector_type(4)));
typedef float f32x4 __attribute__((ext_vector_type(4)));
typedef float f32x16 __attribute__((ext_vector_type(16)));
typedef float f32x4u __attribute__((ext_vector_type(4), aligned(4)));
typedef unsigned u32x4 __attribute__((ext_vector_type(4)));
typedef unsigned u32x2 __attribute__((ext_vector_type(2)));
typedef float f32x2_t __attribute__((ext_vector_type(2)));
typedef __bf16 bf16x2_t __attribute__((ext_vector_type(2)));

constexpr int DM = 1024, CTX_B = 16, CTX_T = 256, LAT_B = 8, LAT_T = 1024, DEPTH = 4, PAST = 512;
constexpr int MCTX = CTX_B * CTX_T, MLAT = LAT_B * LAT_T, MTOK = MCTX + MLAT;
constexpr int NZ = 2048, NVT = 768, NIN = NZ + NVT, DFF = 4096, IN_DIM = 2832;
constexpr float LN_EPS = 1e-5f;
constexpr float DN_ALPHA = 1.681792830507429f;
constexpr float LOG2E = 1.4426950408889634f;
constexpr float QSCALE = 0.125f * LOG2E;
constexpr int ZC_MQ = 0, ZC_MK = 256, ZC_MO = 512, ZC_SQ = 768, ZC_SK = 1152, ZC_NQ = 1280, ZC_NK = 1664;
constexpr int VR_MV = 0, VR_SV = 256, VR_NV = 384;
constexpr size_t O_Y = 0, O_SWAK = 12582912, O_SWAV = 14680064, O_NATK = 16777216, O_NATV = 23068672, O_MC = 29360128, O_MN = 31457280, O_MM = 31490048;

constexpr size_t CTL_BYTES = 1u << 20;
constexpr size_t SZ_WIN_L = (size_t)NIN * DM * 2, SZ_WOUT_L = (size_t)DM * DM * 2, SZ_W1_L = (size_t)DFF * DM * 2;
constexpr size_t WS_WIN = CTL_BYTES;
constexpr size_t WS_WOUT = WS_WIN + 4 * SZ_WIN_L;
constexpr size_t WS_W1 = WS_WOUT + 4 * SZ_WOUT_L;
constexpr size_t WS_W2 = WS_W1 + 4 * SZ_W1_L;
constexpr size_t WS_BINZ = WS_W2 + 4 * SZ_W1_L;
constexpr size_t WS_WGT = WS_BINZ + 45056;
constexpr size_t WS_BG = WS_WGT + 262144;
constexpr size_t WS_MODS = WS_BG + 256;
constexpr size_t WS_ROPE = WS_MODS + 884736;
constexpr size_t WS_RPB2 = WS_ROPE + 8192;
constexpr int RPB_STRIDE = 544, RPB_OFF = 32;
constexpr size_t WS_CKS = WS_RPB2 + 52224;
constexpr size_t WS_CVS = WS_CKS + 4194304;
constexpr size_t WS_CKN = WS_CVS + 4194304;
constexpr size_t WS_CVN = WS_CKN + 12582912;
constexpr size_t WS_H = WS_CVN + 12582912;
constexpr size_t WS_HM = WS_H + (size_t)MTOK * DM * 2;
constexpr size_t WS_GATES = WS_HM + (size_t)MTOK * DM * 2;
constexpr size_t WS_X1 = WS_GATES + (size_t)MTOK * 16 * 4;
constexpr size_t WS_OV = WS_X1 + (size_t)MTOK * DM * 4;
constexpr size_t OV_Z = 0;
constexpr size_t OV_VT = OV_Z + (size_t)MTOK * NZ * 2;
constexpr size_t OV_MIX = OV_VT + (size_t)NVT * MTOK * 2;
constexpr size_t OV_U = OV_MIX + (size_t)MTOK * DM * 2;
constexpr size_t OV_CST = OV_U + (size_t)1536 * 4096 * 4;
constexpr size_t OV_NN = OV_CST + (size_t)1536 * 4096 * 2;
constexpr size_t OV_NST = OV_NN + (size_t)1536 * 64 * 4;
constexpr size_t OV_SC = OV_NST + (size_t)1536 * 64 * 4;
constexpr size_t OV_END = OV_SC + (size_t)1536 * 16;
constexpr size_t OV_H1 = 0;
constexpr size_t WS_END = WS_OV + (OV_END > (size_t)MTOK * DFF * 2 ? OV_END : (size_t)MTOK * DFF * 2);
static_assert(WS_BINZ % 256 == 0 && WS_WGT % 256 == 0 && WS_MODS % 256 == 0 && WS_ROPE % 256 == 0 && WS_RPB2 % 256 == 0 && WS_CKS % 256 == 0 && WS_H % 256 == 0 && WS_OV % 256 == 0, "ws align");
constexpr int CW_BAR = 4096, CW_Q = 16384;

constexpr int RING_BYTES = 131072;
constexpr int LDSCTL_OFF = RING_BYTES, MISC_OFF = LDSCTL_OFF + 320;
constexpr int LDS_BYTES = 147456;

DI float bf2f(bf16_t u) { return __uint_as_float(((unsigned)u) << 16); }
DI float bfs2f(short u) { return __uint_as_float(((unsigned)(unsigned short)u) << 16); }
DI unsigned pk2(float lo, float hi) { f32x2_t v = {lo, hi}; bf16x2_t b = __builtin_convertvector(v, bf16x2_t); return __builtin_bit_cast(unsigned, b); }
DI int crow(int r, int hi) { return (r & 3) + 8 * (r >> 2) + 4 * hi; }
DI float swap_max(float v) { auto rr = __builtin_amdgcn_permlane32_swap(__float_as_uint(v), __float_as_uint(v), false, false); return fmaxf(__uint_as_float(rr[0]), __uint_as_float(rr[1])); }
DI float swap_sum(float v) { auto rr = __builtin_amdgcn_permlane32_swap(__float_as_uint(v), __float_as_uint(v), false, false); return __uint_as_float(rr[0]) + __uint_as_float(rr[1]); }
DI float shfl_f(float v, int src) { return __int_as_float(__builtin_amdgcn_ds_bpermute(src << 2, __float_as_int(v))); }
DI float swap_other(float v, int h2) { auto rr = __builtin_amdgcn_permlane32_swap(__float_as_uint(v), __float_as_uint(v), false, false); return __uint_as_float(h2 ? rr[0] : rr[1]); }
DI float wave_sum(float v, int lane) {
#pragma unroll
    for (int o = 1; o < 32; o <<= 1) v += shfl_f(v, lane ^ o);
    return swap_sum(v);
}
DI float fexp(float x) { return __builtin_amdgcn_exp2f(x * LOG2E); }
#define MFMA32(a, b, c) __builtin_amdgcn_mfma_f32_32x32x16_bf16((a), (b), (c), 0, 0, 0)
#define LDS_WAIT() asm volatile("s_waitcnt lgkmcnt(0)" ::: "memory")
#define VM_WAIT() asm volatile("s_waitcnt vmcnt(0)" ::: "memory")

namespace pg8 {
constexpr int BM = 256, BK = 64, HALF = 128, HTB = HALF * BK * 2, STAGE_BYTES = 8 * HTB, NXCD = 8, WGM = 8;
__host__ __device__ __forceinline__ int lds_byte(int r, int c) { const int st = (r >> 4) * 2 + (c >> 5), rr = r & 15, cc = c & 31, ob = rr * 64 + cc * 2; return st * 1024 + (ob ^ (((ob >> 9) & 1) << 5)); }
__host__ __device__ __forceinline__ void stage_rc(int b, int& R, int& C) { const int st = b / 1024, sb = b % 1024, swz = sb ^ (((sb >> 9) & 1) << 5); R = (st >> 1) * 16 + swz / 64; C = (st & 1) * 32 + (swz % 64) / 2; }
__host__ __device__ __forceinline__ int perm32(int rho) { const int n = rho >> 4, i = rho & 15; return 8 * (i >> 2) + 4 * n + (i & 3); }
struct Unit { int pm, pn; };
struct StaticOrder {
    int nM, nN, nwg, G, c;
    DI void init(int nM_, int nN_, int G_, int c_) { nM = nM_; nN = nN_; nwg = nM * nN; G = G_; c = c_; }
    DI bool next(int i, Unit& u) const {
        const long L = (long)i * G + c; if (L >= nwg) return false;
        int wgid = (int)L; { const int q = nwg / NXCD, r = nwg % NXCD, xcd = wgid % NXCD, off = wgid / NXCD; wgid = (xcd < r ? xcd * (q + 1) : r * (q + 1) + (xcd - r) * q) + off; }
        const int nig = WGM * nN, gid = wgid / nig, fm = gid * WGM, gsz = (nM - fm) < WGM ? (nM - fm) : WGM;
        u.pm = fm + ((wgid % nig) % gsz); u.pn = (wgid % nig) / gsz; return true;
    }
};
enum { EPI_G1 = 0, EPI_RELU2 = 1, EPI_RES = 2 };
struct Epi {
    int kind;
    bf16_t* Z; bf16_t* VT; const float* binz; const float* rope;
    bf16_t* H1;
    const float* xres_ctx; const float* xres_lat; float* out; const float* gvec;
};
struct Gemm { const bf16_t* A; const bf16_t* Bt; int K; int nM, nN, nNz; bool perm; };

DI void epilogue(const Epi& E, const f32x4 (&acc)[2][2][4][2], const Unit& u, int wr, int wc, int fr, int fq) {
    if (E.kind == EPI_G1) {
        if (u.pn < 8) {
            const int row0 = u.pm * BM + wr * 64 + fr, col0 = u.pn * BM + wc * 32 + 8 * fq;
            const bool do_rope = (u.pn == 3 || u.pn == 4) && (u.pm >= 16);
            f32x4 bv[2][2];
#pragma unroll
            for (int bj = 0; bj < 2; ++bj)
#pragma unroll
                for (int n = 0; n < 2; ++n) bv[bj][n] = *(const f32x4*)(E.binz + col0 + bj * HALF + 4 * n);
#pragma unroll
            for (int ai = 0; ai < 2; ++ai)
#pragma unroll
                for (int m = 0; m < 4; ++m) {
                    const int row = row0 + ai * HALF + m * 16;
                    bf16_t* rowp = E.Z + (size_t)row * NZ + col0;
                    f32x4 cs[4];
                    if (do_rope) {
                        const int t = (row - MCTX) & (LAT_T - 1);
                        const int pos = (wc & 1) ? (t & 63) : (t >> 6);
                        const float* rp = E.rope + (pos * 16 + 8 * (fq & 1)) * 2;
#pragma unroll
                        for (int k = 0; k < 4; ++k) cs[k] = *(const f32x4*)(rp + 4 * k);
                    }
#pragma unroll
                    for (int bj = 0; bj < 2; ++bj) {
                        f32x4 v0 = acc[ai][bj][m][0] + bv[bj][0], v1 = acc[ai][bj][m][1] + bv[bj][1];
                        if (do_rope) {
                            f32x4 p0, p1;
#pragma unroll
                            for (int e = 0; e < 4; ++e) { p0[e] = swap_other(v0[e], fq >> 1); p1[e] = swap_other(v1[e], fq >> 1); }
                            const float sg = (fq < 2) ? -1.f : 1.f;
                            f32x4 o0, o1;
                            o0[0] = v0[0] * cs[0][0] + sg * p0[0] * cs[0][1]; o0[1] = v0[1] * cs[0][2] + sg * p0[1] * cs[0][3];
                            o0[2] = v0[2] * cs[1][0] + sg * p0[2] * cs[1][1]; o0[3] = v0[3] * cs[1][2] + sg * p0[3] * cs[1][3];
                            o1[0] = v1[0] * cs[2][0] + sg * p1[0] * cs[2][1]; o1[1] = v1[1] * cs[2][2] + sg * p1[1] * cs[2][3];
                            o1[2] = v1[2] * cs[3][0] + sg * p1[2] * cs[3][1]; o1[3] = v1[3] * cs[3][2] + sg * p1[3] * cs[3][3];
                            v0 = o0; v1 = o1;
                        }
                        u32x4 w; w.x = pk2(v0[0], v0[1]); w.y = pk2(v0[2], v0[3]); w.z = pk2(v1[0], v1[1]); w.w = pk2(v1[2], v1[3]);
                        *(u32x4*)(rowp + bj * HALF) = w;
                    }
                }
        } else {
            const int f0 = (u.pn - 8) * BM + wr * 64 + fr, col0 = u.pm * BM + wc * 32 + 8 * fq;
#pragma unroll
            for (int ai = 0; ai < 2; ++ai)
#pragma unroll
                for (int m = 0; m < 4; ++m) {
                    const int f = f0 + ai * HALF + m * 16;
                    const float b = E.binz[NZ + f];
                    bf16_t* rowp = E.VT + (size_t)f * MTOK + col0;
#pragma unroll
                    for (int bj = 0; bj < 2; ++bj) {
                        const f32x4 v0 = acc[ai][bj][m][0] + b, v1 = acc[ai][bj][m][1] + b;
                        u32x4 w; w.x = pk2(v0[0], v0[1]); w.y = pk2(v0[2], v0[3]); w.z = pk2(v1[0], v1[1]); w.w = pk2(v1[2], v1[3]);
                        *(u32x4*)(rowp + bj * HALF) = w;
                    }
                }
        }
    } else if (E.kind == EPI_RELU2) {
        const int row0 = u.pm * BM + wr * 64 + fr, col0 = u.pn * BM + wc * 32 + 8 * fq;
#pragma unroll
        for (int ai = 0; ai < 2; ++ai)
#pragma unroll
            for (int m = 0; m < 4; ++m) {
                bf16_t* rowp = E.H1 + (size_t)(row0 + ai * HALF + m * 16) * DFF + col0;
#pragma unroll
                for (int bj = 0; bj < 2; ++bj) {
                    f32x4 v0 = acc[ai][bj][m][0], v1 = acc[ai][bj][m][1];
#pragma unroll
                    for (int e = 0; e < 4; ++e) { const float a = fmaxf(v0[e], 0.f), b = fmaxf(v1[e], 0.f); v0[e] = a * a; v1[e] = b * b; }
                    u32x4 w; w.x = pk2(v0[0], v0[1]); w.y = pk2(v0[2], v0[3]); w.z = pk2(v1[0], v1[1]); w.w = pk2(v1[2], v1[3]);
                    *(u32x4*)(rowp + bj * HALF) = w;
                }
            }
    } else {
        const int row0 = u.pm * BM + wr * 64 + fr, col0 = u.pn * BM + wc * 32 + 4 * fq;
        const int bidx = (u.pm < 16) ? 0 : 1 + ((u.pm - 16) >> 2);
        const float* gv = E.gvec + (size_t)bidx * 6144 + col0;
        f32x4 g[2][2];
#pragma unroll
        for (int bj = 0; bj < 2; ++bj)
#pragma unroll
            for (int n = 0; n < 2; ++n) g[bj][n] = *(const f32x4*)(gv + bj * HALF + n * 16);
#pragma unroll
        for (int ai = 0; ai < 2; ++ai)
#pragma unroll
            for (int m = 0; m < 4; ++m) {
                const int row = row0 + ai * HALF + m * 16;
                const float* xr = (row < MCTX ? E.xres_ctx + (size_t)row * DM : E.xres_lat + (size_t)(row - MCTX) * DM) + col0;
                float* op = E.out + (size_t)row * DM + col0;
#pragma unroll
                for (int bj = 0; bj < 2; ++bj)
#pragma unroll
                    for (int n = 0; n < 2; ++n) {
                        const f32x4 xv = *(const f32x4*)(xr + bj * HALF + n * 16);
                        *(f32x4*)(op + bj * HALF + n * 16) = xv * DN_ALPHA + g[bj][n] * acc[ai][bj][m][n];
                    }
            }
    }
}

DI void gemm_phase(LAS unsigned char* lds, const Gemm g, const StaticOrder& S, const Epi& E, const int tid) {
    const int wid = __builtin_amdgcn_readfirstlane(tid >> 6), lane = tid & 63, wr = wid >> 2, wc = wid & 3, fr = lane & 15, fq = lane >> 4;
    const int K = g.K, nt = K / BK;
    unsigned voffA[2], voffB[2];
#pragma unroll
    for (int i = 0; i < 2; ++i) { int R, C; stage_rc(tid * 16 + i * 8192, R, C); const int Rb = g.perm ? ((R & ~31) + perm32(R & 31)) : R;
        voffA[i] = (unsigned)(R * K + C) * 2u; voffB[i] = (unsigned)(Rb * K + C) * 2u; }
    const size_t kstep = (size_t)(BK * 2);
    const size_t hstep = (size_t)HALF * K * 2;
    const size_t tstep = 2 * hstep;
    const unsigned ldsw = (unsigned)wid * 1024u;
    const int aoff = lds_byte(wr * 64 + fr, fq * 8), boff = lds_byte(wc * 32 + fr, fq * 8);
#define PG8_SA(b, h) (((b) * 2 + (h)) * HTB)
#define PG8_SB(b, h) ((4 + (b) * 2 + (h)) * HTB)
#define PG8_STAGE(bufoff, gbase, voff) do { _Pragma("unroll") for (int _i = 0; _i < 2; ++_i) \
        __builtin_amdgcn_global_load_lds((const unsigned*)((const char*)(gbase) + (voff)[_i]), (LAS unsigned*)(lds + (bufoff) + ldsw + _i * 8192), 16, 0, 0); } while (0)
#define PG8_LDA(dst, b, h) do { _Pragma("unroll") for (int m = 0; m < 4; ++m) _Pragma("unroll") for (int k = 0; k < 2; ++k) dst[m][k] = *(const LAS bf16x8*)(lds + PG8_SA(b, h) + aoff + m * 2048 + k * 1024); } while (0)
#define PG8_LDB(dst, b, h) do { _Pragma("unroll") for (int n = 0; n < 2; ++n) _Pragma("unroll") for (int k = 0; k < 2; ++k) dst[n][k] = *(const LAS bf16x8*)(lds + PG8_SB(b, h) + boff + n * 2048 + k * 1024); } while (0)
#define PG8_MMA(ai, bj, At, Bt) do { __builtin_amdgcn_s_setprio(1); _Pragma("unroll") for (int m = 0; m < 4; ++m) _Pragma("unroll") for (int n = 0; n < 2; ++n) _Pragma("unroll") for (int k = 0; k < 2; ++k) \
        acc[ai][bj][m][n] = __builtin_amdgcn_mfma_f32_16x16x32_bf16(Bt[n][k], At[m][k], acc[ai][bj][m][n], 0, 0, 0); __builtin_amdgcn_s_setprio(0); } while (0)
#define PG8_WAIT_V(n) asm volatile("s_waitcnt vmcnt(" #n ")" ::: "memory")
#define PG8_WAIT_L(n) asm volatile("s_waitcnt lgkmcnt(" #n ")" ::: "memory")
#define PG8_BAR __builtin_amdgcn_s_barrier()
#define PG8_SCHED __builtin_amdgcn_sched_barrier(0)
#define PG8_PTRS(u, pa, pb) do { const bool sw_ = (u).pn >= g.nNz; const char* a_ = (const char*)g.A + (size_t)(u).pm * tstep; const char* b_ = (const char*)g.Bt + (size_t)(u).pn * tstep; pa = sw_ ? b_ : a_; pb = sw_ ? a_ : b_; } while (0)
    Unit cur, nxt; int ui = 0;
    if (!S.next(0, cur)) return;
    f32x4 acc[2][2][4][2];
#pragma unroll
    for (int a = 0; a < 2; ++a)
#pragma unroll
        for (int b = 0; b < 2; ++b)
#pragma unroll
            for (int m = 0; m < 4; ++m)
#pragma unroll
                for (int n = 0; n < 2; ++n) acc[a][b][m][n] = (f32x4){0.f, 0.f, 0.f, 0.f};
    bf16x8 At[4][2], B0[2][2], B1[2][2];
    const char* cA; const char* cB; PG8_PTRS(cur, cA, cB);
    PG8_STAGE(PG8_SB(0, 0), cB, voffB); PG8_STAGE(PG8_SB(0, 1), cB + hstep, voffB); PG8_STAGE(PG8_SA(0, 0), cA, voffA); PG8_STAGE(PG8_SA(0, 1), cA + hstep, voffA);
    if (wr == 1) PG8_BAR;
    PG8_WAIT_V(2); PG8_BAR;
    PG8_STAGE(PG8_SB(1, 0), cB + kstep, voffB); PG8_STAGE(PG8_SA(1, 0), cA + kstep, voffA); PG8_STAGE(PG8_SB(1, 1), cB + hstep + kstep, voffB);
    PG8_WAIT_V(6); PG8_BAR;
    for (;;) {
        const bool has_next = S.next(ui + 1, nxt);
        const char* nA = cA; const char* nB = cB; if (has_next) PG8_PTRS(nxt, nA, nB);
        for (int t = 0; t < nt; t += 2) {
            const bool last = (t == nt - 2);
            const char* a1 = cA + (size_t)(t + 1) * kstep;
            const char* a2 = last ? nA : cA + (size_t)(t + 2) * kstep; const char* b2 = last ? nB : cB + (size_t)(t + 2) * kstep;
            const char* a3 = a2 + kstep; const char* b3 = b2 + kstep;
            PG8_LDB(B0, 0, 0); PG8_LDB(B1, 0, 1); PG8_SCHED; PG8_LDA(At, 0, 0); PG8_STAGE(PG8_SA(1, 1), a1 + hstep, voffA);
            PG8_WAIT_V(8); PG8_WAIT_L(0); PG8_BAR; PG8_MMA(0, 0, At, B0); PG8_MMA(0, 1, At, B1); PG8_BAR; PG8_SCHED;
            PG8_LDA(At, 0, 1); PG8_STAGE(PG8_SB(0, 0), b2, voffB); PG8_STAGE(PG8_SB(0, 1), b2 + hstep, voffB); PG8_STAGE(PG8_SA(0, 0), a2, voffA);
            PG8_WAIT_V(8); PG8_WAIT_L(0); PG8_BAR; PG8_MMA(1, 0, At, B0); PG8_MMA(1, 1, At, B1); PG8_BAR; PG8_SCHED;
            PG8_LDB(B0, 1, 0); PG8_LDB(B1, 1, 1); PG8_SCHED; PG8_LDA(At, 1, 0); PG8_STAGE(PG8_SA(0, 1), a2 + hstep, voffA);
            PG8_WAIT_V(8); PG8_WAIT_L(0); PG8_BAR; PG8_MMA(0, 0, At, B0); PG8_MMA(0, 1, At, B1); PG8_BAR; PG8_SCHED;
            PG8_LDA(At, 1, 1); PG8_STAGE(PG8_SB(1, 0), b3, voffB); PG8_STAGE(PG8_SB(1, 1), b3 + hstep, voffB); PG8_STAGE(PG8_SA(1, 0), a3, voffA);
            PG8_WAIT_V(8); PG8_WAIT_L(0); PG8_BAR; PG8_MMA(1, 0, At, B0); PG8_MMA(1, 1, At, B1); PG8_BAR; PG8_SCHED;
        }
        if (wr == 0) PG8_BAR;
        epilogue(E, acc, cur, wr, wc, fr, fq);
        if (!has_next) break;
#pragma unroll
        for (int a = 0; a < 2; ++a)
#pragma unroll
            for (int b = 0; b < 2; ++b)
#pragma unroll
                for (int m = 0; m < 4; ++m)
#pragma unroll
                    for (int n = 0; n < 2; ++n) acc[a][b][m][n] = (f32x4){0.f, 0.f, 0.f, 0.f};
        cur = nxt; cA = nA; cB = nB; ++ui;
        if (wr == 1) PG8_BAR;
    }
    PG8_WAIT_V(0);
    PG8_BAR;
#undef PG8_SA
#undef PG8_SB
#undef PG8_STAGE
#undef PG8_LDA
#undef PG8_LDB
#undef PG8_MMA
#undef PG8_WAIT_V
#undef PG8_WAIT_L
#undef PG8_BAR
#undef PG8_SCHED
#undef PG8_PTRS
}
}

typedef GAS unsigned gu32;
#define RLX_AGENT __ATOMIC_RELAXED, __HIP_MEMORY_SCOPE_AGENT
#define XB_TMO      128
#define XB_XCNT(j)  (256  + 64 * (j))
#define XB_XSUB(j)  (1280 + 64 * (j))
#define XB_XGEN(j)  (2304 + 64 * (j))
#define XB_TOP      3328
#define XB_TOPGEN   3392
#define XCD_BAR_WORDS 3456
#define XB_SPIN_CAP (1u << 18)
DI unsigned xb_ld(unsigned* p)              { return __hip_atomic_load(p, __ATOMIC_RELAXED, __HIP_MEMORY_SCOPE_AGENT); }
DI unsigned xb_add(unsigned* p, unsigned v) { return __hip_atomic_fetch_add(p, v, __ATOMIC_RELAXED, __HIP_MEMORY_SCOPE_AGENT); }
DI unsigned xb_xcc_id() { return (unsigned)__builtin_amdgcn_s_getreg((3 << 11) | 20) & 0xFu; }
#define XB_SPIN(cond, bar) do { unsigned _sp = 0; while (cond) { __builtin_amdgcn_s_sleep(1); \
    if ((++_sp & 255u) == 0u) { if (xb_ld(&(bar)[XB_TMO])) break; if (_sp > XB_SPIN_CAP) { atomicAdd(&(bar)[XB_TMO], 1u); break; } } } } while (0)
struct XcdBarrier { unsigned* bar; unsigned x; volatile LAS unsigned* st; };
DI XcdBarrier xcd_barrier_post(unsigned* bar, volatile LAS unsigned* st) {
    XcdBarrier b; b.bar = bar; b.x = xb_xcc_id(); b.st = st;
    if (threadIdx.x == 0) (void)xb_add(&bar[XB_XCNT(b.x)], 1u);
    return b;
}
DI void xcd_barrier_complete(unsigned* bar, unsigned x, unsigned& nloc, unsigned& nx) {
    const unsigned G = gridDim.x * gridDim.y * gridDim.z;
    unsigned sum, cnt, mine, sp = 0u;
    for (;;) {
        sum = 0u; cnt = 0u; mine = 0u;
#pragma unroll 1
        for (unsigned j = 0; j < 16; ++j) { const unsigned c = xb_ld(&bar[XB_XCNT(j)]); sum += c; cnt += (c > 0u) ? 1u : 0u; }
        mine = xb_ld(&bar[XB_XCNT(x)]);
        if (sum == G) break;
        __builtin_amdgcn_s_sleep(1);
        if ((++sp & 255u) == 0u) { if (xb_ld(&bar[XB_TMO])) break; if (sp > XB_SPIN_CAP) { atomicAdd(&bar[XB_TMO], 1u); break; } }
    }
    nloc = mine > 0u ? mine : 1u; nx = cnt > 0u ? cnt : 1u;
}
DI void xcd_barrier(const XcdBarrier& b) {
    asm volatile("s_waitcnt vmcnt(0)" ::: "memory");
    __syncthreads();
    if (threadIdx.x == 0) {
        unsigned* bar = b.bar;
        __builtin_amdgcn_s_waitcnt(0);
        unsigned nloc = b.st[0], nx = b.st[1];
        if (nloc == 0u) { xcd_barrier_complete(bar, b.x, nloc, nx); b.st[0] = nloc; b.st[1] = nx; }
        const unsigned old = xb_add(&bar[XB_XSUB(b.x)], 1u);
        const unsigned gen = old / nloc;
        if (old + 1u == (gen + 1u) * nloc) {
            __builtin_amdgcn_fence(__ATOMIC_RELEASE, "agent");
            asm volatile("s_waitcnt vmcnt(0)" ::: "memory");
            const unsigned og = xb_add(&bar[XB_TOP], 1u);
            const unsigned tg = og / nx;
            if (og + 1u == (tg + 1u) * nx) xb_add(&bar[XB_TOPGEN], 1u);
            else XB_SPIN(xb_ld(&bar[XB_TOPGEN]) == tg, bar);
            __builtin_amdgcn_fence(__ATOMIC_ACQUIRE, "agent");
            xb_add(&bar[XB_XGEN(b.x)], 1u);
            asm volatile("s_waitcnt vmcnt(0)" ::: "memory");
        } else {
            XB_SPIN(xb_ld(&bar[XB_XGEN(b.x)]) == gen, bar);
            __builtin_amdgcn_fence(__ATOMIC_ACQUIRE, "agent");
            asm volatile("s_waitcnt vmcnt(0)" ::: "memory");
        }
    }
    __syncthreads();
}

struct Args { const float* in[26]; float* out; unsigned char* ws; int ph_lo, ph_hi, li, pad; };
enum { I_XP = 0, I_XS, I_CSK, I_CSV, I_CNK, I_CNV, I_SC, I_SN, I_SM, I_C, I_CCTX, I_WADA, I_BADA, I_WIN, I_BIN, I_FB, I_NG, I_SINK, I_RPB, I_WOUT, I_LN1G, I_LN1B, I_W1, I_W2, I_LN2G, I_LN2B };

struct Ctx {
    const Args* a;
    LAS unsigned char* lds;
    unsigned char* ws;
    int tid, lane, wave, G, vcu, phase;
};

DI int win_src_col(int n) {
    if (n < 256) return n;
    if (n < 512) return 256 + (n - 256);
    if (n < 768) return 768 + (n - 512);
    if (n < 1152) return 1040 + (n - 768);
    if (n < 1280) return 1424 + (n - 1152);
    if (n < 1664) return 1680 + (n - 1280);
    if (n < 2048) return 2064 + (n - 1664);
    n -= 2048;
    if (n < 256) return 512 + n;
    if (n < 384) return 1552 + (n - 256);
    return 2448 + (n - 384);
}
DI float win_scale(int n) {
    if (n >= 256 && n < 512) return 0.125f;
    if ((n >= 768 && n < 1152) || (n >= 1280 && n < 1664)) return QSCALE;
    return 1.f;
}

DI void tr_item(const float* src, size_t ld_src, bf16_t* dst, size_t ld_dst, float scale, LAS float* scr, int lane) {
#pragma unroll 8
    for (int i = 0; i < 32; ++i) { const int kk = 2 * i + (lane >> 5); scr[kk * 33 + (lane & 31)] = src[(size_t)kk * ld_src + (lane & 31)] * scale; }
    LDS_WAIT(); asm volatile("" ::: "memory");
    const int c = lane & 7;
#pragma unroll
    for (int j = 0; j < 4; ++j) { const int n = (lane >> 3) + 8 * j; const LAS float* s = scr + (8 * c) * 33 + n;
        u32x4 o; o.x = pk2(s[0 * 33], s[1 * 33]); o.y = pk2(s[2 * 33], s[3 * 33]); o.z = pk2(s[4 * 33], s[5 * 33]); o.w = pk2(s[6 * 33], s[7 * 33]);
        *(u32x4*)(dst + (size_t)n * ld_dst + 8 * c) = o; }
    LDS_WAIT(); asm volatile("" ::: "memory");
}

DI void p0_prologue(const Ctx& X) {
    const Args& A = *X.a;
    unsigned char* ws = X.ws;
    {
        LAS float* sv = (LAS float*)X.lds;
        LAS float* red = (LAS float*)(X.lds + 9 * 1024 * 4);
        for (int e = X.tid; e < 9 * 1024; e += 512) {
            const int j = e >> 10, k = e & 1023;
            const float c = (j == 0) ? A.in[I_CCTX][k] : A.in[I_C][(j - 1) * 1024 + k];
            sv[e] = c / (1.f + fexp(-c));
        }
        __syncthreads();
        float* MODS = (float*)(ws + WS_MODS);
        for (int u = X.vcu; u < DEPTH * 96; u += X.G) {
            const int l = u / 96, cb = u % 96;
            const float* wp = A.in[I_WADA] + (size_t)l * 1024 * 6144 + (size_t)(X.wave * 128) * 6144 + cb * 64 + X.lane;
            float acc[9];
#pragma unroll
            for (int j = 0; j < 9; ++j) acc[j] = 0.f;
            for (int k0 = 0; k0 < 128; k0 += 8) {
                float wv[8];
#pragma unroll
                for (int kk = 0; kk < 8; ++kk) wv[kk] = wp[(size_t)(k0 + kk) * 6144];
#pragma unroll
                for (int kk = 0; kk < 8; ++kk)
#pragma unroll
                    for (int j = 0; j < 9; ++j) acc[j] += sv[j * 1024 + X.wave * 128 + k0 + kk] * wv[kk];
            }
#pragma unroll
            for (int j = 0; j < 9; ++j) red[(X.wave * 9 + j) * 64 + X.lane] = acc[j];
            __syncthreads();
            for (int e = X.tid; e < 576; e += 512) {
                const int j = e >> 6, c = e & 63; float s = 0.f;
#pragma unroll
                for (int w = 0; w < 8; ++w) s += red[(w * 9 + j) * 64 + c];
                MODS[((size_t)l * 9 + j) * 6144 + cb * 64 + c] = s + A.in[I_BADA][l * 6144 + cb * 64 + c];
            }
            __syncthreads();
        }
        __syncthreads();
    }
    {
        LAS float* scr = (LAS float*)(X.lds + X.wave * 16384);
        const int gw = X.vcu * 8 + X.wave, NGW = X.G * 8;
        constexpr int I_IN = 16 * 88, I_OUT = 16 * 32, I_1 = 16 * 128, I_2 = 64 * 32, I_L = I_IN + I_OUT + I_1 + I_2;
        constexpr int I_W = DEPTH * I_L, I_CS = 64 * 16, I_CN = 192 * 16, I_TOT = I_W + I_CS + I_CN;
        for (int it = gw; it < I_TOT; it += NGW) {
            if (it < I_W) {
                const int l = it / I_L; int r = it % I_L;
                if (r < I_IN) { const int kb = r / 88, nb = r % 88, n0 = nb * 32;
                    tr_item(A.in[I_WIN] + (size_t)l * 1024 * IN_DIM + (size_t)(kb * 64) * IN_DIM + win_src_col(n0), IN_DIM,
                            (bf16_t*)(ws + WS_WIN + l * SZ_WIN_L) + (size_t)n0 * DM + kb * 64, DM, win_scale(n0), scr, X.lane); continue; }
                r -= I_IN;
                if (r < I_OUT) { const int kb = r / 32, nb = r % 32;
                    tr_item(A.in[I_WOUT] + (size_t)l * DM * DM + (size_t)(kb * 64) * DM + nb * 32, DM,
                            (bf16_t*)(ws + WS_WOUT + l * SZ_WOUT_L) + (size_t)(nb * 32) * DM + kb * 64, DM, 1.f, scr, X.lane); continue; }
                r -= I_OUT;
                if (r < I_1) { const int kb = r / 128, nb = r % 128;
                    tr_item(A.in[I_W1] + (size_t)l * DM * DFF + (size_t)(kb * 64) * DFF + nb * 32, DFF,
                            (bf16_t*)(ws + WS_W1 + l * SZ_W1_L) + (size_t)(nb * 32) * DM + kb * 64, DM, 1.f, scr, X.lane); continue; }
                r -= I_1;
                { const int kb = r / 32, nb = r % 32;
                    tr_item(A.in[I_W2] + (size_t)l * DFF * DM + (size_t)(kb * 64) * DM + nb * 32, DM,
                            (bf16_t*)(ws + WS_W2 + l * SZ_W1_L) + (size_t)(nb * 32) * DFF + kb * 64, DFF, 1.f, scr, X.lane); }
            } else if (it < I_W + I_CS) {
                const int r = it - I_W, mat = r / 16, sub = r % 16, kb = sub / 2, nb = sub % 2;
                tr_item(A.in[I_CSV] + (size_t)mat * 512 * 64 + (size_t)(kb * 64) * 64 + nb * 32, 64,
                        (bf16_t*)(ws + WS_CVS) + (size_t)mat * 64 * 512 + (size_t)(nb * 32) * 512 + kb * 64, 512, 1.f, scr, X.lane);
            } else {
                const int r = it - I_W - I_CS, mat = r / 16, sub = r % 16, kb = sub / 2, nb = sub % 2;
                tr_item(A.in[I_CNV] + (size_t)mat * 512 * 64 + (size_t)(kb * 64) * 64 + nb * 32, 64,
                        (bf16_t*)(ws + WS_CVN) + (size_t)mat * 64 * 512 + (size_t)(nb * 32) * 512 + kb * 64, 512, 1.f, scr, X.lane);
            }
        }
    }
    {
        const size_t gt = (size_t)X.vcu * 512 + X.tid, NT = (size_t)X.G * 512;
        for (size_t e = gt; e < (size_t)2097152 / 8; e += NT) {
            const f32x4 a = *(const f32x4*)(A.in[I_CSK] + e * 8), b = *(const f32x4*)(A.in[I_CSK] + e * 8 + 4);
            u32x4 o; o.x = pk2(a[0], a[1]); o.y = pk2(a[2], a[3]); o.z = pk2(b[0], b[1]); o.w = pk2(b[2], b[3]);
            *(u32x4*)((bf16_t*)(ws + WS_CKS) + e * 8) = o;
        }
        for (size_t e = gt; e < (size_t)6291456 / 8; e += NT) {
            const f32x4 a = *(const f32x4*)(A.in[I_CNK] + e * 8), b = *(const f32x4*)(A.in[I_CNK] + e * 8 + 4);
            u32x4 o; o.x = pk2(a[0], a[1]); o.y = pk2(a[2], a[3]); o.z = pk2(b[0], b[1]); o.w = pk2(b[2], b[3]);
            *(u32x4*)((bf16_t*)(ws + WS_CKN) + e * 8) = o;
        }
        float* binz = (float*)(ws + WS_BINZ);
        for (size_t e = gt; e < (size_t)DEPTH * NIN; e += NT) { const int l = (int)(e / NIN), n = (int)(e % NIN); binz[e] = A.in[I_BIN][l * IN_DIM + win_src_col(n)] * win_scale(n); }
        float* wgt = (float*)(ws + WS_WGT);
        for (size_t e = gt; e < (size_t)DEPTH * 16 * 1024; e += NT) { const int l = (int)(e >> 14), t = (int)((e >> 10) & 15), k = (int)(e & 1023); wgt[e] = A.in[I_WIN][(size_t)l * 1024 * IN_DIM + (size_t)k * IN_DIM + 1024 + t]; }
        float* bg = (float*)(ws + WS_BG);
        for (size_t e = gt; e < (size_t)DEPTH * 16; e += NT) bg[e] = A.in[I_BIN][(e >> 4) * IN_DIM + 1024 + (e & 15)];
        float* rope = (float*)(ws + WS_ROPE);
        for (size_t e = gt; e < 64 * 16; e += NT) { const int pos = (int)(e >> 4), i = (int)(e & 15);
            const float fr = __builtin_amdgcn_exp2f(-(float)i * (13.287712379549449f / 16.f)); const float rev = __builtin_amdgcn_fractf((float)pos * fr * 0.15915494309189535f);
            rope[2 * e] = __builtin_amdgcn_cosf(rev); rope[2 * e + 1] = __builtin_amdgcn_sinf(rev); }
        float* rpb2 = (float*)(ws + WS_RPB2);
        for (size_t e = gt; e < (size_t)DEPTH * 6 * RPB_STRIDE; e += NT) { const int tb_ = (int)(e / RPB_STRIDE), o_ = (int)(e % RPB_STRIDE) - RPB_OFF; rpb2[e] = (o_ >= 0 && o_ < 465) ? A.in[I_RPB][tb_ * 465 + o_] * LOG2E : 0.f; }
    }
}

DI void row_pass(const Ctx& X, int mode, int l) {
    const Args& A = *X.a; unsigned char* ws = X.ws;
    const int lg = (mode == 2) ? l + 1 : l;
    const bool do_gates = (mode == 0) || (mode == 2 && l < DEPTH - 1);
    LAS float* wg = (LAS float*)X.lds;
    if (do_gates) {
        const float* wgt = (const float*)(ws + WS_WGT) + (size_t)lg * 16 * 1024;
        for (int e = X.tid; e < 16 * 1024 / 4; e += 512) *(LAS f32x4*)(wg + 4 * e) = *(const f32x4*)(wgt + 4 * e);
    }
    __syncthreads();
    const float* MODS = (const float*)(ws + WS_MODS);
    float* X1 = (float*)(ws + WS_X1);
    float* XO = A.out + O_Y;
    bf16_t* Hd = (bf16_t*)(ws + (mode == 1 ? WS_HM : WS_H));
    float* GT = (float*)(ws + WS_GATES);
    const float* lng = (mode == 1) ? A.in[I_LN1G] + l * DM : A.in[I_LN2G] + l * DM;
    const float* lnb = (mode == 1) ? A.in[I_LN1B] + l * DM : A.in[I_LN2B] + l * DM;
    const int gw = X.vcu * 8 + X.wave, NGW = X.G * 8;
    for (int row = gw; row < MTOK; row += NGW) {
        const int bidx = (row < MCTX) ? 0 : 1 + ((row - MCTX) >> 10);
        const float* src = (mode == 0) ? (row < MCTX ? A.in[I_XP] + (size_t)row * DM : A.in[I_XS] + (size_t)(row - MCTX) * DM) : X1 + (size_t)row * DM;
        f32x4 v[4];
#pragma unroll
        for (int j = 0; j < 4; ++j) v[j] = *(const f32x4*)(src + 256 * j + 4 * X.lane);
        if (mode != 0) {
            float s = 0.f;
#pragma unroll
            for (int j = 0; j < 4; ++j) s += (v[j][0] + v[j][1]) + (v[j][2] + v[j][3]);
            const float mean = wave_sum(s, X.lane) * (1.f / DM); float s2 = 0.f;
#pragma unroll
            for (int j = 0; j < 4; ++j) { v[j] = v[j] - mean; s2 += (v[j][0] * v[j][0] + v[j][1] * v[j][1]) + (v[j][2] * v[j][2] + v[j][3] * v[j][3]); }
            const float rstd = 1.f / sqrtf(wave_sum(s2, X.lane) * (1.f / DM) + LN_EPS);
            float* dst = (mode == 1) ? X1 + (size_t)row * DM : XO + (size_t)row * DM;
#pragma unroll
            for (int j = 0; j < 4; ++j) {
                const f32x4 g = *(const f32x4*)(lng + 256 * j + 4 * X.lane), b = *(const f32x4*)(lnb + 256 * j + 4 * X.lane);
                v[j] = v[j] * rstd * g + b;
                *(f32x4*)(dst + 256 * j + 4 * X.lane) = v[j];
            }
        }
        if (mode == 2 && l == DEPTH - 1) continue;
        const float* md = MODS + ((size_t)lg * 9 + bidx) * 6144 + (mode == 1 ? 3072 : 0);
        f32x4 h[4];
#pragma unroll
        for (int j = 0; j < 4; ++j) {
            const f32x4 sh = *(const f32x4*)(md + 256 * j + 4 * X.lane), sc = *(const f32x4*)(md + 1024 + 256 * j + 4 * X.lane);
            h[j] = v[j] * (sc + 1.f) + sh;
            u32x2 o; o.x = pk2(h[j][0], h[j][1]); o.y = pk2(h[j][2], h[j][3]);
            *(u32x2*)(Hd + (size_t)row * DM + 256 * j + 4 * X.lane) = o;
        }
        if (do_gates) {
            float gs[16];
#pragma unroll
            for (int t = 0; t < 16; ++t) {
                float s = 0.f;
#pragma unroll
                for (int j = 0; j < 4; ++j) { const f32x4 w = *(const LAS f32x4*)(wg + t * 1024 + 256 * j + 4 * X.lane); s += (h[j][0] * w[0] + h[j][1] * w[1]) + (h[j][2] * w[2] + h[j][3] * w[3]); }
                gs[t] = wave_sum(s, X.lane);
            }
            float mine = 0.f;
#pragma unroll
            for (int t = 0; t < 16; ++t) mine = (X.lane == t) ? gs[t] : mine;
            if (X.lane < 16) GT[(size_t)row * 16 + X.lane] = mine + ((const float*)(ws + WS_BG))[lg * 16 + X.lane];
        }
    }
}

struct AttnU {
    int nc0; const bf16_t* k0; const bf16_t* v0;
    int nc1; const bf16_t* k1; const bf16_t* v1; int tok1;
    int kind;
    int krow0; const float* rpb2;
    bool has_sink; float sink2;
};
constexpr float ATT_THR = 6.f;
constexpr int ATT_BUF = 16384, ATT_VOFF = 8192;
DI int att_koff(int row, int p) { return row * 128 + ((p ^ ((row >> 1) & 7)) << 4); }
DI int att_voff(int d, int q) { return d * 128 + ((q ^ ((d >> 1) & 15)) << 3); }
DI void attn_unit(const Ctx& X, const AttnU& D, int t0, int kcol0, int wlo, int whi, const bf16_t* qrow, int qtok, int rq, int qc, bf16_t* outp) {
    const int lane = X.lane, r32 = lane & 31, h2 = lane >> 5, tid = X.tid;
    LAS unsigned char* lbase = X.lds;
    bf16x8 qf[4];
#pragma unroll
    for (int ks = 0; ks < 4; ++ks) qf[ks] = *(const bf16x8*)(qrow + 16 * ks + 8 * h2);
    f32x16 o[2];
#pragma unroll
    for (int r = 0; r < 16; ++r) { o[0][r] = 0.f; o[1][r] = 0.f; }
    float m = -1e30f, lsum = 0.f;
    const int nc = D.nc0 + D.nc1;
    const int wstart = min(max(rq - 4, 0), 8);
    unsigned colbits = 0u; int cbase = 0;
    if (D.kind == 2) {
        const int cs = min(max(qc - 8, 0), 48);
#pragma unroll
        for (int r = 0; r < 16; ++r) { const int kcol = kcol0 + 4 * h2 + (r & 3) + 8 * (r >> 2); if (kcol >= cs && kcol < cs + 16) colbits |= 1u << r; }
        cbase = kcol0 + 4 * h2 - qc + 15;
    }
    const int srow = tid >> 3, sp = tid & 7;
    const int kdst = att_koff(srow, sp);
    const int vx = (srow >> 1) & 15, vdst = ATT_VOFF + srow * 128 + ((((2 * sp) ^ vx) & ~1) << 3); const bool vswap = vx & 1;
    u32x4 kreg, vreg;
#define ATT_GLOAD(c) do { \
        const bf16_t* kp_; const bf16_t* vp_; \
        if ((c) < D.nc0) { kp_ = D.k0 + (size_t)(64 * (c) + srow) * 64 + 8 * sp; vp_ = D.v0 + (size_t)srow * 512 + 64 * (c) + 8 * sp; } \
        else { const int tc_ = D.tok1 + 64 * ((c) - D.nc0); kp_ = D.k1 + (size_t)(tc_ + srow) * NZ + 8 * sp; vp_ = D.v1 + (size_t)srow * MTOK + tc_ + 8 * sp; } \
        kreg = *(const u32x4*)kp_; vreg = *(const u32x4*)vp_; \
    } while (0)
#define ATT_LWRITE(bufoff) do { \
        *(LAS u32x4*)(lbase + (bufoff) + kdst) = kreg; \
        u32x4 vv_; vv_.x = vswap ? vreg.z : vreg.x; vv_.y = vswap ? vreg.w : vreg.y; vv_.z = vswap ? vreg.x : vreg.z; vv_.w = vswap ? vreg.y : vreg.w; \
        *(LAS u32x4*)(lbase + (bufoff) + vdst) = vv_; \
    } while (0)
    __syncthreads();
    ATT_GLOAD(0); ATT_LWRITE(0);
    __syncthreads();
    for (int c = 0; c < nc; ++c) {
        const int bufoff = (c & 1) * ATT_BUF;
        if (c + 1 < nc) ATT_GLOAD(c + 1);
        int ntile = 2, T0 = 0, mode = 0, aux = 0;
        if (c >= D.nc0) {
            const int cc = c - D.nc0;
            if (D.kind == 1) { aux = D.tok1 + 64 * cc; mode = 1; }
            else if (D.kind == 2) { aux = D.krow0 + cc; mode = 2; T0 = kcol0; ntile = (aux >= wlo && aux < whi) ? 1 : 0; }
        }
#pragma unroll 1
        for (int j = 0; j < ntile; ++j, T0 += 32) {
            int tk = 0;
            if (mode == 1) { tk = aux + T0; if (tk < t0 - 128 || tk > t0 + 128) continue; }
            f32x16 s;
#pragma unroll
            for (int r = 0; r < 16; ++r) s[r] = 0.f;
            {
                const int krow = T0 + r32; const int kx = (krow >> 1) & 7;
                LAS unsigned char* kb = lbase + bufoff + krow * 128;
#pragma unroll
                for (int ks = 0; ks < 4; ++ks) { const bf16x8 kf = *(const LAS bf16x8*)(kb + (((2 * ks + h2) ^ kx) << 4)); s = MFMA32(kf, qf[ks], s); }
            }
            if (mode == 1) {
                if (tk == t0 + 128 || tk == t0 - 128) {
                    const int kp0 = tk + 4 * h2;
#pragma unroll
                    for (int r = 0; r < 16; ++r) { const int kpos = kp0 + (r & 3) + 8 * (r >> 2); const int dd = qtok - kpos; if (dd > 128 || dd < -128) s[r] = -1e30f; }
                }
            } else if (mode == 2) {
                const int krow = aux;
                const bool rowok = (krow >= wstart) && (krow < wstart + 8);
                const float* bp = D.rpb2 + min(max(krow - rq + 7, 0), 14) * 31 + cbase;
#pragma unroll
                for (int g = 0; g < 4; ++g) {
                    const f32x4u bb = *(const f32x4u*)(bp + 8 * g);
#pragma unroll
                    for (int e = 0; e < 4; ++e) { const int r = 4 * g + e; const bool ok = rowok && ((colbits >> r) & 1u); s[r] = ok ? s[r] + bb[e] : -1e30f; }
                }
            }
            float tm = fmaxf(fmaxf(s[0], s[1]), fmaxf(s[2], s[3]));
#pragma unroll
            for (int r = 4; r < 16; r += 4) tm = fmaxf(tm, fmaxf(fmaxf(s[r], s[r + 1]), fmaxf(s[r + 2], s[r + 3])));
            tm = swap_max(tm);
            if (__any(tm > m + ATT_THR)) {
                const float mn = fmaxf(m, tm), alpha = __builtin_amdgcn_exp2f(m - mn);
                m = mn; lsum *= alpha;
#pragma unroll
                for (int r = 0; r < 16; ++r) { o[0][r] *= alpha; o[1][r] *= alpha; }
            }
            float ps = 0.f;
#pragma unroll
            for (int r = 0; r < 16; ++r) { s[r] = __builtin_amdgcn_exp2f(s[r] - m); ps += s[r]; }
            lsum += ps;
            u32x4 p0, p1;
            p0.x = pk2(s[0], s[1]); p0.y = pk2(s[2], s[3]); p0.z = pk2(s[4], s[5]); p0.w = pk2(s[6], s[7]);
            p1.x = pk2(s[8], s[9]); p1.y = pk2(s[10], s[11]); p1.z = pk2(s[12], s[13]); p1.w = pk2(s[14], s[15]);
            const bf16x8 pb0 = __builtin_bit_cast(bf16x8, p0), pb1 = __builtin_bit_cast(bf16x8, p1);
            const int q0 = (T0 >> 2) + h2;
#pragma unroll
            for (int dt = 0; dt < 2; ++dt) {
                const int d = 32 * dt + r32; const int vxr = (d >> 1) & 15;
                LAS unsigned char* vb = lbase + bufoff + ATT_VOFF + d * 128;
                const s16x4 a0 = *(const LAS s16x4*)(vb + (((q0) ^ vxr) << 3)), a1 = *(const LAS s16x4*)(vb + (((q0 + 2) ^ vxr) << 3));
                const s16x4 b0 = *(const LAS s16x4*)(vb + (((q0 + 4) ^ vxr) << 3)), b1 = *(const LAS s16x4*)(vb + (((q0 + 6) ^ vxr) << 3));
                o[dt] = MFMA32(__builtin_shufflevector(a0, a1, 0, 1, 2, 3, 4, 5, 6, 7), pb0, o[dt]);
                o[dt] = MFMA32(__builtin_shufflevector(b0, b1, 0, 1, 2, 3, 4, 5, 6, 7), pb1, o[dt]);
            }
        }
        if (c + 1 < nc) ATT_LWRITE(ATT_BUF - bufoff);
        __syncthreads();
    }
#undef ATT_GLOAD
#undef ATT_LWRITE
    float lt = swap_sum(lsum);
    if (D.has_sink) lt += __builtin_amdgcn_exp2f(D.sink2 - m);
    const float inv = 1.f / lt;
#pragma unroll
    for (int dt = 0; dt < 2; ++dt)
#pragma unroll
        for (int g = 0; g < 4; ++g) {
            u32x2 w; w.x = pk2(o[dt][4 * g] * inv, o[dt][4 * g + 1] * inv); w.y = pk2(o[dt][4 * g + 2] * inv, o[dt][4 * g + 3] * inv);
            *(u32x2*)(outp + 32 * dt + 8 * g + 4 * h2) = w;
        }
}

DI void chunk_gates(const float* gates, int dir, int h, float fb, int lane, LAS float* sb, LAS float* sa, LAS float* sA, float& Bc, float& Amax) {
    const float* g = gates + (size_t)lane * 16;
    const float li = g[8 * dir + h], gf = g[8 * dir + 4 + h] + fb;
    const float lf = fminf(gf, 0.f) - __builtin_amdgcn_logf(1.f + fexp(-fabsf(gf))) * 0.6931471805599453f;
    float b = lf;
    if (dir == 0) {
#pragma unroll
        for (int off = 1; off < 64; off <<= 1) { const float t = shfl_f(b, lane - off); if (lane >= off) b += t; }
    } else {
#pragma unroll
        for (int off = 1; off < 64; off <<= 1) { const float t = shfl_f(b, lane + off); if (lane + off < 64) b += t; }
    }
    const float a = li - b; float Ar = a;
    if (dir == 0) {
#pragma unroll
        for (int off = 1; off < 64; off <<= 1) { const float t = shfl_f(Ar, lane - off); if (lane >= off) Ar = fmaxf(Ar, t); }
    } else {
#pragma unroll
        for (int off = 1; off < 64; off <<= 1) { const float t = shfl_f(Ar, lane + off); if (lane + off < 64) Ar = fmaxf(Ar, t); }
    }
    sb[lane] = b; sa[lane] = a; sA[lane] = Ar;
    const int el = dir == 0 ? 63 : 0;
    Bc = shfl_f(b, el); Amax = shfl_f(Ar, el);
    LDS_WAIT(); asm volatile("" ::: "memory");
}

DI void mlstm_p1(const Ctx& X, int l, int is_lat, int b, int h, int dir, int tb) {
    const Args& A = *X.a; unsigned char* ws = X.ws;
    const int T = is_lat ? LAT_T : CTX_T, nch = T / 64;
    const int rowbase = is_lat ? MCTX + b * LAT_T : b * CTX_T;
    const int cdbase = is_lat ? ((b * 4 + h) * 2) * 16 : 1024 + ((b * 4 + h) * 2) * 4;
    const bf16_t* Z = (const bf16_t*)(ws + WS_OV + OV_Z) + (size_t)rowbase * NZ;
    const bf16_t* VT = (const bf16_t*)(ws + WS_OV + OV_VT) + (size_t)(VR_MV + 64 * h) * MTOK + rowbase;
    const float* GT = (const float*)(ws + WS_GATES) + (size_t)rowbase * 16;
    float* U = (float*)(ws + WS_OV + OV_U); bf16_t* CST = (bf16_t*)(ws + WS_OV + OV_CST);
    float* NN = (float*)(ws + WS_OV + OV_NN); float* NST = (float*)(ws + WS_OV + OV_NST); float* SC = (float*)(ws + WS_OV + OV_SC);
    (void)Z; (void)VT; (void)GT; (void)U; (void)CST; (void)NN; (void)NST; (void)SC; (void)nch; (void)cdbase; (void)A;
    const int lane = X.lane, r32 = lane & 31, h2 = lane >> 5;
    LAS float* sb = (LAS float*)(X.lds + X.wave * 2048); LAS float* sa = sb + 64; LAS float* sA = sb + 128; LAS float* sw = sb + 192;
    {
        bf16x8 ident[2];
#pragma unroll
        for (int e = 0; e < 2; ++e)
#pragma unroll
            for (int j = 0; j < 8; ++j) ident[e][j] = (r32 == 16 * e + 8 * h2 + j) ? (short)0x3F80 : (short)0;
        {
            const int cd = cdbase + dir * nch + tb, tok0 = tb * 64;
            const float fb = A.in[I_FB][(l * 2 + dir) * 4 + h];
            float Bc, Amax;
            chunk_gates(GT + (size_t)tok0 * 16, dir, h, fb, lane, sb, sa, sA, Bc, Amax);
            sw[lane] = fexp(sa[lane] - Amax);
            LDS_WAIT(); asm volatile("" ::: "memory");
            f32x16 acc[2][2];
#pragma unroll
            for (int i = 0; i < 2; ++i)
#pragma unroll
                for (int j = 0; j < 2; ++j)
#pragma unroll
                    for (int r = 0; r < 16; ++r) acc[i][j][r] = 0.f;
            float nacc[2] = {0.f, 0.f};
#pragma unroll
            for (int st = 0; st < 2; ++st) {
                bf16x8 kf[4];
                const bf16_t* kp = Z + (size_t)(tok0 + 32 * st + r32) * NZ + ZC_MK + 64 * h + 8 * h2;
#pragma unroll
                for (int ks = 0; ks < 4; ++ks) kf[ks] = *(const bf16x8*)(kp + 16 * ks);
                bf16x8 va[2][2];
                const bf16_t* vp = VT + (size_t)r32 * MTOK + tok0 + 32 * st + 4 * h2;
#pragma unroll
                for (int vt = 0; vt < 2; ++vt)
#pragma unroll
                    for (int s2 = 0; s2 < 2; ++s2) { const s16x4 a0 = *(const s16x4*)(vp + (size_t)(32 * vt) * MTOK + 16 * s2), a1 = *(const s16x4*)(vp + (size_t)(32 * vt) * MTOK + 16 * s2 + 8);
                        va[vt][s2] = __builtin_shufflevector(a0, a1, 0, 1, 2, 3, 4, 5, 6, 7); }
                float wr_[16];
#pragma unroll
                for (int r = 0; r < 16; ++r) wr_[r] = sw[32 * st + crow(r, h2)];
#pragma unroll
                for (int dt = 0; dt < 2; ++dt) {
                    f32x16 x;
#pragma unroll
                    for (int r = 0; r < 16; ++r) x[r] = 0.f;
                    x = MFMA32(kf[2 * dt], ident[0], x);
                    x = MFMA32(kf[2 * dt + 1], ident[1], x);
#pragma unroll
                    for (int r = 0; r < 16; ++r) { x[r] *= wr_[r]; nacc[dt] += x[r]; }
                    u32x4 p0, p1;
                    p0.x = pk2(x[0], x[1]); p0.y = pk2(x[2], x[3]); p0.z = pk2(x[4], x[5]); p0.w = pk2(x[6], x[7]);
                    p1.x = pk2(x[8], x[9]); p1.y = pk2(x[10], x[11]); p1.z = pk2(x[12], x[13]); p1.w = pk2(x[14], x[15]);
                    const bf16x8 xb0 = __builtin_bit_cast(bf16x8, p0), xb1 = __builtin_bit_cast(bf16x8, p1);
#pragma unroll
                    for (int vt = 0; vt < 2; ++vt) { acc[vt][dt] = MFMA32(va[vt][0], xb0, acc[vt][dt]); acc[vt][dt] = MFMA32(va[vt][1], xb1, acc[vt][dt]); }
                }
            }
            float* Ug = U + (size_t)cd * 4096;
#pragma unroll
            for (int vt = 0; vt < 2; ++vt)
#pragma unroll
                for (int dt = 0; dt < 2; ++dt)
#pragma unroll
                    for (int r = 0; r < 16; ++r) Ug[(32 * vt + crow(r, h2)) * 64 + 32 * dt + r32] = acc[vt][dt][r];
#pragma unroll
            for (int dt = 0; dt < 2; ++dt) { const float t = swap_sum(nacc[dt]); if (h2 == 0) NN[(size_t)cd * 64 + 32 * dt + r32] = t; }
            if (lane == 0) { SC[cd * 4 + 0] = Bc; SC[cd * 4 + 1] = Amax; }
        }
    }
}

DI void mlstm_p2(const Ctx& X, int l, int is_lat, int b, int h, int dir) {
    const Args& A = *X.a; unsigned char* ws = X.ws;
    const int T = is_lat ? LAT_T : CTX_T, nch = T / 64;
    const int rowbase = is_lat ? MCTX + b * LAT_T : b * CTX_T;
    const int cdbase = is_lat ? ((b * 4 + h) * 2) * 16 : 1024 + ((b * 4 + h) * 2) * 4;
    const bf16_t* Z = (const bf16_t*)(ws + WS_OV + OV_Z) + (size_t)rowbase * NZ;
    const bf16_t* VT = (const bf16_t*)(ws + WS_OV + OV_VT) + (size_t)(VR_MV + 64 * h) * MTOK + rowbase;
    const float* GT = (const float*)(ws + WS_GATES) + (size_t)rowbase * 16;
    float* U = (float*)(ws + WS_OV + OV_U); bf16_t* CST = (bf16_t*)(ws + WS_OV + OV_CST);
    float* NN = (float*)(ws + WS_OV + OV_NN); float* NST = (float*)(ws + WS_OV + OV_NST); float* SC = (float*)(ws + WS_OV + OV_SC);
    (void)Z; (void)VT; (void)GT; (void)U; (void)CST; (void)NN; (void)NST; (void)SC; (void)nch; (void)cdbase; (void)A;
    const int tid = X.tid;
    float C[8], nv = 0.f, m = 0.f;
    if (is_lat) {
        const float* c0 = A.in[I_SC] + ((((size_t)b * DEPTH + l) * 2 + dir) * 4 + h) * 4096;
#pragma unroll
        for (int i = 0; i < 8; ++i) C[i] = c0[tid + 512 * i];
        if (tid < 64) nv = A.in[I_SN][((((size_t)b * DEPTH + l) * 2 + dir) * 4 + h) * 64 + tid];
        m = A.in[I_SM][(((size_t)b * DEPTH + l) * 2 + dir) * 4 + h];
    } else {
#pragma unroll
        for (int i = 0; i < 8; ++i) C[i] = 0.f;
    }
    float Ur[16][8], nnr[16], bcr[16], amr[16];
#pragma unroll
    for (int step = 0; step < 16; ++step) {
        if (step < nch) {
            const int cd = cdbase + dir * nch + (dir ? nch - 1 - step : step);
#pragma unroll
            for (int i = 0; i < 8; ++i) Ur[step][i] = U[(size_t)cd * 4096 + tid + 512 * i];
            nnr[step] = (tid < 64) ? NN[(size_t)cd * 64 + tid] : 0.f;
            bcr[step] = SC[cd * 4 + 0]; amr[step] = SC[cd * 4 + 1];
        }
    }
#pragma unroll
    for (int step = 0; step < 16; ++step) {
        if (step < nch) {
            const int cd = cdbase + dir * nch + (dir ? nch - 1 - step : step);
            bf16_t* cs = CST + (size_t)cd * 4096;
#pragma unroll
            for (int i = 0; i < 8; ++i) cs[tid + 512 * i] = (bf16_t)(pk2(C[i], 0.f) & 0xffffu);
            if (tid < 64) NST[(size_t)cd * 64 + tid] = nv;
            if (tid == 0) SC[cd * 4 + 2] = m;
            const float M63 = fmaxf(m, amr[step]), f1 = fexp(m - M63), f2 = fexp(amr[step] - M63);
#pragma unroll
            for (int i = 0; i < 8; ++i) C[i] = f1 * C[i] + f2 * Ur[step][i];
            nv = f1 * nv + f2 * nnr[step];
            m = bcr[step] + M63;
        }
    }
    if (!is_lat) {
        float* oc = A.out + O_MC + ((((size_t)b * DEPTH + l) * 2 + dir) * 4 + h) * 4096;
#pragma unroll
        for (int i = 0; i < 8; ++i) oc[tid + 512 * i] = C[i];
        if (tid < 64) A.out[O_MN + ((((size_t)b * DEPTH + l) * 2 + dir) * 4 + h) * 64 + tid] = nv;
        if (tid == 0) A.out[O_MM + (((size_t)b * DEPTH + l) * 2 + dir) * 4 + h] = m;
    }
}

DI void mlstm_p3(const Ctx& X, int l, int is_lat, int b, int h, int tb, int th) {
    const Args& A = *X.a; unsigned char* ws = X.ws;
    const int T = is_lat ? LAT_T : CTX_T, nch = T / 64;
    const int rowbase = is_lat ? MCTX + b * LAT_T : b * CTX_T;
    const int cdbase = is_lat ? ((b * 4 + h) * 2) * 16 : 1024 + ((b * 4 + h) * 2) * 4;
    const bf16_t* Z = (const bf16_t*)(ws + WS_OV + OV_Z) + (size_t)rowbase * NZ;
    const bf16_t* VT = (const bf16_t*)(ws + WS_OV + OV_VT) + (size_t)(VR_MV + 64 * h) * MTOK + rowbase;
    const float* GT = (const float*)(ws + WS_GATES) + (size_t)rowbase * 16;
    float* U = (float*)(ws + WS_OV + OV_U); bf16_t* CST = (bf16_t*)(ws + WS_OV + OV_CST);
    float* NN = (float*)(ws + WS_OV + OV_NN); float* NST = (float*)(ws + WS_OV + OV_NST); float* SC = (float*)(ws + WS_OV + OV_SC);
    (void)Z; (void)VT; (void)GT; (void)U; (void)CST; (void)NN; (void)NST; (void)SC; (void)nch; (void)cdbase; (void)A;
    const int lane = X.lane, r32 = lane & 31, h2 = lane >> 5;
    LAS float* sb = (LAS float*)(X.lds + X.wave * 2048); LAS float* sa = sb + 64; LAS float* sA = sb + 128;
    bf16_t* MIX = (bf16_t*)(ws + WS_OV + OV_MIX) + (size_t)rowbase * DM;
    {
        const int tok0 = tb * 64, t = 32 * th + r32;
        bf16x8 qf[4];
#pragma unroll
        for (int ks = 0; ks < 4; ++ks) qf[ks] = *(const bf16x8*)(Z + (size_t)(tok0 + t) * NZ + ZC_MQ + 64 * h + 16 * ks + 8 * h2);
        f32x16 hs[2];
#pragma unroll
        for (int r = 0; r < 16; ++r) { hs[0][r] = 0.f; hs[1][r] = 0.f; }
#pragma unroll 1
        for (int dir = 0; dir < 2; ++dir) {
            const int cd = cdbase + dir * nch + tb;
            const float fb = A.in[I_FB][(l * 2 + dir) * 4 + h];
            const float mc = SC[cd * 4 + 2];
            float Bc, Amax;
            chunk_gates(GT + (size_t)tok0 * 16, dir, h, fb, lane, sb, sa, sA, Bc, Amax);
            const float Mt = fmaxf(mc, sA[t]), wprev = fexp(mc - Mt), mt = sb[t] + Mt;
            f32x16 num[2];
#pragma unroll
            for (int r = 0; r < 16; ++r) { num[0][r] = 0.f; num[1][r] = 0.f; }
            {
                const bf16_t* cs = CST + (size_t)cd * 4096 + r32 * 64 + 8 * h2;
#pragma unroll
                for (int ks = 0; ks < 4; ++ks)
#pragma unroll
                    for (int vt = 0; vt < 2; ++vt) { const bf16x8 cf = *(const bf16x8*)(cs + (32 * vt) * 64 + 16 * ks); num[vt] = MFMA32(cf, qf[ks], num[vt]); }
            }
#pragma unroll
            for (int r = 0; r < 16; ++r) { num[0][r] *= wprev; num[1][r] *= wprev; }
            float nq = 0.f;
            {
                const float* nsp = NST + (size_t)cd * 64 + 8 * h2;
#pragma unroll
                for (int ks = 0; ks < 4; ++ks) {
                    const f32x4 n0 = *(const f32x4*)(nsp + 16 * ks), n1 = *(const f32x4*)(nsp + 16 * ks + 4);
#pragma unroll
                    for (int j = 0; j < 4; ++j) nq += n0[j] * bfs2f(qf[ks][j]) + n1[j] * bfs2f(qf[ks][4 + j]);
                }
            }
            float den = 0.f;
#pragma unroll
            for (int st = 0; st < 2; ++st) {
                f32x16 s;
#pragma unroll
                for (int r = 0; r < 16; ++r) s[r] = 0.f;
#pragma unroll
                for (int ks = 0; ks < 4; ++ks) { const bf16x8 kf = *(const bf16x8*)(Z + (size_t)(tok0 + 32 * st + r32) * NZ + ZC_MK + 64 * h + 8 * h2 + 16 * ks); s = MFMA32(kf, qf[ks], s); }
#pragma unroll
                for (int r = 0; r < 16; ++r) {
                    const int sidx = 32 * st + crow(r, h2);
                    const bool ok = dir == 0 ? (sidx <= t) : (sidx >= t);
                    const float w = ok ? fexp(sa[sidx] - Mt) : 0.f;
                    s[r] *= w; den += s[r];
                }
                u32x4 p0, p1;
                p0.x = pk2(s[0], s[1]); p0.y = pk2(s[2], s[3]); p0.z = pk2(s[4], s[5]); p0.w = pk2(s[6], s[7]);
                p1.x = pk2(s[8], s[9]); p1.y = pk2(s[10], s[11]); p1.z = pk2(s[12], s[13]); p1.w = pk2(s[14], s[15]);
                const bf16x8 pb0 = __builtin_bit_cast(bf16x8, p0), pb1 = __builtin_bit_cast(bf16x8, p1);
#pragma unroll
                for (int vt = 0; vt < 2; ++vt) {
                    const bf16_t* vp = VT + (size_t)(32 * vt + r32) * MTOK + tok0 + 32 * st + 4 * h2;
                    const s16x4 a0 = *(const s16x4*)(vp), a1 = *(const s16x4*)(vp + 8), b0 = *(const s16x4*)(vp + 16), b1 = *(const s16x4*)(vp + 24);
                    num[vt] = MFMA32(__builtin_shufflevector(a0, a1, 0, 1, 2, 3, 4, 5, 6, 7), pb0, num[vt]);
                    num[vt] = MFMA32(__builtin_shufflevector(b0, b1, 0, 1, 2, 3, 4, 5, 6, 7), pb1, num[vt]);
                }
            }
            nq = swap_sum(nq);
            den = swap_sum(den) + wprev * nq;
            const float dn = 1.f / fmaxf(fabsf(den), fexp(-mt));
#pragma unroll
            for (int vt = 0; vt < 2; ++vt)
#pragma unroll
                for (int r = 0; r < 16; ++r) hs[vt][r] += num[vt][r] * dn;
        }
        float s1 = 0.f;
#pragma unroll
        for (int r = 0; r < 16; ++r) s1 += hs[0][r] + hs[1][r];
        const float mu = swap_sum(s1) * (1.f / 64.f);
        float s2 = 0.f;
#pragma unroll
        for (int r = 0; r < 16; ++r) { hs[0][r] -= mu; hs[1][r] -= mu; s2 += hs[0][r] * hs[0][r] + hs[1][r] * hs[1][r]; }
        const float rstd = 1.f / sqrtf(swap_sum(s2) * (1.f / 64.f) + LN_EPS);
        const bf16_t* mo = Z + (size_t)(tok0 + t) * NZ + ZC_MO + 64 * h;
        const float* ng = A.in[I_NG] + l * 256 + 64 * h;
        bf16_t* op = MIX + (size_t)(tok0 + t) * DM + 64 * h;
#pragma unroll
        for (int vt = 0; vt < 2; ++vt)
#pragma unroll
            for (int g = 0; g < 4; ++g) {
                const int d0 = 32 * vt + 8 * g + 4 * h2;
                const s16x4 mv = *(const s16x4*)(mo + d0);
                const f32x4 gv = *(const f32x4*)(ng + d0);
                float y[4];
#pragma unroll
                for (int e = 0; e < 4; ++e) { const float og = 1.f / (1.f + fexp(-bfs2f(mv[e]))); y[e] = hs[vt][4 * g + e] * rstd * gv[e] * og; }
                u32x2 w; w.x = pk2(y[0], y[1]); w.y = pk2(y[2], y[3]);
                *(u32x2*)(op + d0) = w;
            }
    }
}

constexpr int PM_LAT = 1 + ((PROBE_DUP >> 10) & 1), PM_CATT = 1 + ((PROBE_DUP >> 11) & 1), PM_P1 = 1 + ((PROBE_DUP >> 12) & 1), PM_P3 = 1 + ((PROBE_DUP >> 13) & 1), PM_P2 = 1 + ((PROBE_DUP >> 14) & 1);
constexpr int NU_P1 = 192 * PM_P1, NU_SLAT = 192 * PM_LAT, NU_NLAT = 192 * PM_LAT, NU_CATT = 192 * PM_CATT, NU_COPY = 16, NU_P2 = 192 * PM_P2, NU_P3 = 192 * PM_P3;
constexpr int NU_A = NU_SLAT + NU_NLAT + NU_P1 + NU_COPY, NU_C = NU_P3 + NU_CATT;
DI void mix_phase(const Ctx& X0, int l, const XcdBarrier& bar) {
    const Args& A = *X0.a; unsigned char* ws = X0.ws;
    const bf16_t* Z = (const bf16_t*)(ws + WS_OV + OV_Z);
    const bf16_t* VT = (const bf16_t*)(ws + WS_OV + OV_VT);
    bf16_t* MIX = (bf16_t*)(ws + WS_OV + OV_MIX);
    volatile LAS unsigned* qslot = (volatile LAS unsigned*)(X0.lds + MISC_OFF) + 12;
    int sub = 0;
    for (;;) {
        Ctx X = X0;
        { int t_ = X0.tid; asm volatile("" : "+v"(t_)); X.tid = t_; X.lane = t_ & 63; X.wave = __builtin_amdgcn_readfirstlane(t_ >> 6); }
        gu32* qhead = (gu32*)ws + CW_Q + 64 * (3 * X0.phase + sub);
        __syncthreads();
        if (X.tid == 0) qslot[0] = __hip_atomic_fetch_add(qhead, 1u, __ATOMIC_RELAXED, __HIP_MEMORY_SCOPE_AGENT);
        __syncthreads();
        const int u = (int)qslot[0];
        if (u >= (sub == 0 ? NU_A : (sub == 1 ? NU_P2 : NU_C))) {
            if (sub == 2) break;
            xcd_barrier(bar); __syncthreads();
            ++sub; continue;
        }
        const int lane = X.lane, r32 = lane & 31;
        int r = u;
        int cls;
        if (sub == 0) { if (r < NU_SLAT) cls = 3; else if ((r -= NU_SLAT) < NU_NLAT) cls = 4; else if ((r -= NU_NLAT) < NU_P1) cls = 0; else { r -= NU_P1; cls = 6; } }
        else if (sub == 1) cls = 1;
        else { if (r < NU_P3) cls = 2; else { r -= NU_P3; cls = 5; } }
        if (cls != 6) r %= 192;
        if (cls == 1) {
            const int is_lat = r < 64 ? 1 : 0; if (!is_lat) r -= 64;
            mlstm_p2(X, l, is_lat, r >> 3, (r >> 1) & 3, r & 1);
            continue;
        }
        if (cls == 2) {
            const int is_lat = r < 128 ? 1 : 0; if (!is_lat) r -= 128;
            const int idx = r * 8 + X.wave;
            const int bh = is_lat ? idx >> 5 : idx >> 3, tb = is_lat ? (idx >> 1) & 15 : (idx >> 1) & 3;
            mlstm_p3(X, l, is_lat, bh >> 2, bh & 3, tb, idx & 1);
            continue;
        }
        if (cls == 0) {
            const int is_lat = r < 128 ? 1 : 0; if (!is_lat) r -= 128;
            const int idx = r * 8 + X.wave;
            mlstm_p1(X, l, is_lat, is_lat ? idx >> 7 : idx >> 5, is_lat ? (idx >> 5) & 3 : (idx >> 3) & 3, is_lat ? (idx >> 4) & 1 : (idx >> 2) & 1, is_lat ? idx & 15 : idx & 3);
            continue;
        }
        if (cls != 6) {
            AttnU D; const bf16_t* qp; bf16_t* op; int qt, rq = 0, qc = 0, t0 = 0, kcol0 = 0, wlo = 0, whi = 0;
            if (cls == 3) {
                const int b = r / 24, qh = (r % 24) / 4, qb = r % 4, kv = qh / 3;
                const int rowbase = MCTX + b * LAT_T; t0 = qb * 256 + X.wave * 32;
                D.nc0 = 8; D.k0 = (const bf16_t*)(ws + WS_CKS) + (size_t)((b * DEPTH + l) * 2 + kv) * 512 * 64; D.v0 = (const bf16_t*)(ws + WS_CVS) + (size_t)((b * DEPTH + l) * 2 + kv) * 64 * 512;
                const int tlo = max(qb * 256 - 128, 0), thi = min(qb * 256 + 384, LAT_T);
                D.nc1 = (thi - tlo) / 64; D.k1 = Z + (size_t)rowbase * NZ + ZC_SK + 64 * kv; D.v1 = VT + (size_t)(VR_SV + 64 * kv) * MTOK + rowbase;
                D.tok1 = tlo; D.kind = 1; D.krow0 = 0; D.rpb2 = (const float*)(ws + WS_RPB2);
                D.has_sink = true; D.sink2 = A.in[I_SINK][l * 6 + qh] * LOG2E;
                qt = t0 + r32;
                qp = Z + (size_t)(rowbase + qt) * NZ + ZC_SQ + 64 * qh; op = MIX + (size_t)(rowbase + qt) * DM + 256 + 64 * qh;
            } else if (cls == 4) {
                const int b = r / 24, h = (r % 24) / 4, rg = r % 4;
                const int rowbase = MCTX + b * LAT_T;
                const int r0 = rg * 4 + (X.wave >> 2) * 2, cb = X.wave & 3;
                rq = r0 + (r32 >> 4); qc = 16 * cb + (r32 & 15); qt = rq * 64 + qc;
                D.nc0 = 8; D.k0 = (const bf16_t*)(ws + WS_CKN) + (size_t)((b * DEPTH + l) * 6 + h) * 512 * 64; D.v0 = (const bf16_t*)(ws + WS_CVN) + (size_t)((b * DEPTH + l) * 6 + h) * 64 * 512;
                wlo = min(max(r0 - 4, 0), 8); whi = min(max(r0 + 1 - 4, 0), 8) + 8; kcol0 = min(max(16 * cb - 8, 0), 32);
                const int ulo = min(max(rg * 4 - 4, 0), 8), uhi = min(max(rg * 4 + 3 - 4, 0), 8) + 8;
                D.krow0 = ulo; D.nc1 = uhi - ulo;
                D.k1 = Z + (size_t)rowbase * NZ + ZC_NK + 64 * h; D.v1 = VT + (size_t)(VR_NV + 64 * h) * MTOK + rowbase;
                D.tok1 = ulo * 64; D.kind = 2; D.rpb2 = (const float*)(ws + WS_RPB2) + (size_t)(l * 6 + h) * RPB_STRIDE + RPB_OFF;
                D.has_sink = false; D.sink2 = 0.f;
                qp = Z + (size_t)(rowbase + qt) * NZ + ZC_NQ + 64 * h; op = MIX + (size_t)(rowbase + qt) * DM + 640 + 64 * h;
            } else {
                const bool is_swa = r < 96; if (!is_swa) r -= 96;
                const int b = r / 6, hh = r % 6, kv = hh / 3;
                const int rowbase = b * CTX_T; qt = X.wave * 32 + r32;
                D.nc0 = 0; D.k0 = Z; D.v0 = VT; D.nc1 = 4; D.tok1 = 0; D.kind = 0; D.krow0 = 0; D.rpb2 = (const float*)(ws + WS_RPB2);
                if (is_swa) { D.k1 = Z + (size_t)rowbase * NZ + ZC_SK + 64 * kv; D.v1 = VT + (size_t)(VR_SV + 64 * kv) * MTOK + rowbase; D.has_sink = true; D.sink2 = A.in[I_SINK][l * 6 + hh] * LOG2E; }
                else { D.k1 = Z + (size_t)rowbase * NZ + ZC_NK + 64 * hh; D.v1 = VT + (size_t)(VR_NV + 64 * hh) * MTOK + rowbase; D.has_sink = false; D.sink2 = 0.f; }
                qp = Z + (size_t)(rowbase + qt) * NZ + (is_swa ? ZC_SQ : ZC_NQ) + 64 * hh; op = MIX + (size_t)(rowbase + qt) * DM + (is_swa ? 256 : 640) + 64 * hh;
            }
            attn_unit(X, D, t0, kcol0, wlo, whi, qp, qt, rq, qc, op);
            continue;
        }
        {
            const int b = r, rowbase = b * CTX_T;
            for (int e = X.tid; e < 256 * 64; e += 512) {
                const int t = e >> 6, c8 = (e & 63) * 8;
                const int zc = (c8 < 128) ? ZC_SK + c8 : ZC_NK + (c8 - 128);
                const bf16x8 v = *(const bf16x8*)(Z + (size_t)(rowbase + t) * NZ + zc);
                float* dst;
                if (c8 < 128) dst = A.out + O_SWAK + ((((size_t)b * DEPTH + l) * 2 + (c8 >> 6)) * 256 + t) * 64 + (c8 & 63);
                else { const int cc = c8 - 128; dst = A.out + O_NATK + ((((size_t)b * DEPTH + l) * 6 + (cc >> 6)) * 256 + t) * 64 + (cc & 63); }
                f32x4 o0, o1;
#pragma unroll
                for (int k = 0; k < 4; ++k) { o0[k] = bfs2f(v[k]); o1[k] = bfs2f(v[4 + k]); }
                *(f32x4*)dst = o0; *(f32x4*)(dst + 4) = o1;
            }
            for (int task = X.wave; task < 64; task += 8) {
                const int hd = task >> 3, tblk = task & 7;
                const bf16_t* src = VT + (size_t)(VR_SV + 64 * hd + lane) * MTOK + rowbase + tblk * 32;
                float* dst = (hd < 2) ? A.out + O_SWAV + ((((size_t)b * DEPTH + l) * 2 + hd) * 256 + tblk * 32) * 64 + lane
                                      : A.out + O_NATV + ((((size_t)b * DEPTH + l) * 6 + (hd - 2)) * 256 + tblk * 32) * 64 + lane;
#pragma unroll
                for (int q = 0; q < 4; ++q) { const bf16x8 v = *(const bf16x8*)(src + 8 * q);
#pragma unroll
                    for (int k = 0; k < 8; ++k) dst[(size_t)(8 * q + k) * 64] = bfs2f(v[k]); }
            }
        }
    }
}

constexpr int ndup_layer() { int n = 0; for (int s = 0; s < 7; ++s) n += (PROBE_DUP >> s) & 1; return n; }
constexpr int LSTRIDE = 7 + ndup_layer(), NPRE = 2 + ((PROBE_DUP >> 7) & 1);
constexpr int NPHASE = NPRE + LSTRIDE * DEPTH;
DI int stage_of(int k) { if (PROBE_DUP == 0) return k; int sidx = -1, c = 0;
#pragma unroll
    for (int s = 0; s < 7; ++s) { if (k == c) sidx = s; ++c; if ((PROBE_DUP >> s) & 1) { if (k == c) sidx = s; ++c; } }
    return sidx; }
__global__ void __launch_bounds__(512, 2) fwd_kernel(Args args) {
    extern __shared__ __attribute__((aligned(16))) unsigned char lds_raw[];
    Ctx X; X.a = &args; X.lds = (LAS unsigned char*)lds_raw; X.ws = args.ws;
    X.tid = threadIdx.x; X.lane = X.tid & 63; X.wave = __builtin_amdgcn_readfirstlane(X.tid >> 6);
    const int wave0 = X.wave;
    X.G = gridDim.x; { const int bx = blockIdx.x; X.vcu = (X.G % 8 == 0) ? (bx % 8) * (X.G / 8) + bx / 8 : bx; }
    volatile LAS unsigned* MISC = (volatile LAS unsigned*)(X.lds + MISC_OFF);
    for (int u = X.tid; u < (LDS_BYTES - LDSCTL_OFF) / 4; u += 512) ((LAS unsigned*)(X.lds + LDSCTL_OFF))[u] = 0u;
    __syncthreads();
    const bool one_launch = (args.ph_hi - args.ph_lo) > 1;
    XcdBarrier bar; bar.bar = (unsigned*)(args.ws) + CW_BAR; bar.x = 0; bar.st = nullptr;
    if (one_launch) bar = xcd_barrier_post((unsigned*)(args.ws) + CW_BAR, MISC + 8);
    const int lo = args.ph_lo, hi = args.ph_hi;
    unsigned char* ws = args.ws;
    for (int ph = lo; ph < hi; ++ph) {
        { unsigned zz_ = 0u; asm volatile("" : "+v"(zz_)); int t_ = (wave0 << 6) | (int)__builtin_amdgcn_mbcnt_hi(~0u, __builtin_amdgcn_mbcnt_lo(~0u, zz_)); asm volatile("" : "+v"(t_)); X.tid = t_; X.lane = t_ & 63; X.wave = __builtin_amdgcn_readfirstlane(t_ >> 6);
          size_t z_ = 0; asm volatile("" : "+s"(z_)); X.ws = args.ws + z_; ws = X.ws; X.phase = ph; }
        const int l = ph < NPRE ? 0 : (ph - NPRE) / LSTRIDE, sidx = ph < NPRE ? -1 : stage_of((ph - NPRE) % LSTRIDE);
        if (ph < NPRE - 1) p0_prologue(X);
        else if (ph == NPRE - 1 || sidx == 3 || sidx == 6) row_pass(X, ph == NPRE - 1 ? 0 : (sidx == 3 ? 1 : 2), l);
        else if (sidx == 1) mix_phase(X, l, bar);
        else {
            pg8::Gemm g; pg8::Epi E{}; int nN;
            if (sidx == 0) {
                g = pg8::Gemm{(const bf16_t*)(ws + WS_H), (const bf16_t*)(ws + WS_WIN + l * SZ_WIN_L), DM, 48, 11, 8, true}; nN = 11;
                E.kind = pg8::EPI_G1; E.Z = (bf16_t*)(ws + WS_OV + OV_Z); E.VT = (bf16_t*)(ws + WS_OV + OV_VT); E.binz = (const float*)(ws + WS_BINZ) + l * NIN; E.rope = (const float*)(ws + WS_ROPE);
            } else if (sidx == 2) {
                g = pg8::Gemm{(const bf16_t*)(ws + WS_OV + OV_MIX), (const bf16_t*)(ws + WS_WOUT + l * SZ_WOUT_L), DM, 48, 4, 4, false}; nN = 4;
                E.kind = pg8::EPI_RES;
                if (l == 0) { E.xres_ctx = args.in[I_XP]; E.xres_lat = args.in[I_XS]; } else { E.xres_ctx = args.out + O_Y; E.xres_lat = args.out + O_Y + (size_t)MCTX * DM; }
                E.out = (float*)(ws + WS_X1); E.gvec = (const float*)(ws + WS_MODS) + (size_t)l * 9 * 6144 + 2048;
            } else if (sidx == 4) {
                g = pg8::Gemm{(const bf16_t*)(ws + WS_HM), (const bf16_t*)(ws + WS_W1 + l * SZ_W1_L), DM, 48, 16, 16, true}; nN = 16;
                E.kind = pg8::EPI_RELU2; E.H1 = (bf16_t*)(ws + WS_OV + OV_H1);
            } else {
                g = pg8::Gemm{(const bf16_t*)(ws + WS_OV + OV_H1), (const bf16_t*)(ws + WS_W2 + l * SZ_W1_L), DFF, 48, 4, 4, false}; nN = 4;
                E.kind = pg8::EPI_RES;
                E.xres_ctx = (const float*)(ws + WS_X1); E.xres_lat = (const float*)(ws + WS_X1) + (size_t)MCTX * DM;
                E.out = (float*)(ws + WS_X1); E.gvec = (const float*)(ws + WS_MODS) + (size_t)l * 9 * 6144 + 5120;
            }
            pg8::StaticOrder S; S.init(48, nN, X.G, (int)blockIdx.x);
            pg8::gemm_phase(X.lds, g, S, E, X.tid);
        }
        if ((PROBE_DUP >> 8) & 1) { xcd_barrier(bar); __syncthreads(); xcd_barrier(bar); __syncthreads(); }
        if (ph + 1 < hi) xcd_barrier(bar); else { VM_WAIT(); }
        __syncthreads();
    }
}

extern "C" void kernel_launch(void* const* d_in, const int* in_sizes, int n_in, void* d_out, int out_size, void* d_ws, size_t ws_size, hipStream_t stream) {
    static int grid = 0;
    if (grid == 0) {
        if (n_in != 26 || ws_size < WS_END) { fprintf(stderr, "kernel_launch: n_in %d ws %zu (need %zu)\n", n_in, ws_size, (size_t)WS_END); grid = -1; return; }
        int dev = 0, cus = 0;
        if (hipGetDevice(&dev) != hipSuccess || hipDeviceGetAttribute(&cus, hipDeviceAttributeMultiprocessorCount, dev) != hipSuccess) { grid = -1; return; }
        if (hipFuncSetAttribute((const void*)fwd_kernel, hipFuncAttributeMaxDynamicSharedMemorySize, LDS_BYTES) != hipSuccess) { grid = -1; return; }
        (void)hipGetLastError();
        grid = cus;
    }
    if (grid < 0) return;
    if (hipMemsetAsync(d_ws, 0, CTL_BYTES, stream) != hipSuccess) return;
    Args a{};
    for (int i = 0; i < 26; ++i) a.in[i] = (const float*)d_in[i];
    a.out = (float*)d_out; a.ws = (unsigned char*)d_ws;
#if MK_N_LAUNCHES == 1
    a.ph_lo = 0; a.ph_hi = NPHASE; a.li = 0;
    hipLaunchKernelGGL(fwd_kernel, dim3(grid), dim3(512), LDS_BYTES, stream, a);
#else
    for (int p = 0; p < NPHASE; ++p) { a.ph_lo = p; a.ph_hi = p + 1; a.li = p; hipLaunchKernelGGL(fwd_kernel, dim3(grid), dim3(512), LDS_BYTES, stream, a); }
#endif
}
```
